# Optimizing an MI355X kernel written in HIP

```python
import math
import jax, jax.numpy as jnp
from jax import lax
import numpy as np

D_MODEL = 1024
BATCH = 4
SEQ = 8192
DEPTH = 2

N_HEADS = 8
HEAD_DIM = D_MODEL // N_HEADS
Q_LORA = 256
KV_LORA = 128
IDX_HEADS = 8
IDX_DIM = 64
IDX_TOPK_MAX = 256
N_KV_GROUPS = 2
HEADS_PER_GROUP = N_HEADS // N_KV_GROUPS
CMP_LEN = 32
CMP_STRIDE = 16
CMP_HID = 256
SLC_BLK = 64
N_SLC_MAX = 16
WIN = 512
D_FF = 4 * D_MODEL
REL_BUCKETS = 32
REL_MAX_DIST = 4096
Q_BLK = 128
EPS = 1e-6
NEG = -1e30
N_A_LAYERS = DEPTH // 2
N_B_LAYERS = DEPTH - N_A_LAYERS

kernel_name = 'yoco_dsa_nsa_hybrid'


def rmsnorm(x, g):
    xf = x.astype(jnp.float32)
    y = xf * lax.rsqrt(jnp.mean(xf * xf, axis=-1, keepdims=True) + EPS)
    return (y * g.astype(jnp.float32)).astype(x.dtype)


def masked_softmax(logits, mask):
    logits = jnp.where(mask, logits, NEG)
    m = jnp.max(logits, axis=-1, keepdims=True)
    e = jnp.where(mask, jnp.exp(logits - m), 0.0)
    return e / jnp.maximum(jnp.sum(e, axis=-1, keepdims=True), 1e-30)


def rel_bucket(dist):
    dist = jnp.maximum(dist, 0)
    exact = REL_BUCKETS // 2
    log_ratio = jnp.log(jnp.maximum(dist, 1).astype(jnp.float32) / exact) / math.log(REL_MAX_DIST / exact)
    large = exact + (log_ratio * (REL_BUCKETS - exact)).astype(jnp.int32)
    return jnp.where(dist < exact, dist, jnp.minimum(large, REL_BUCKETS - 1))


def gather_rows(table, idx):
    return table[idx]


def to_blocks(a):
    return jnp.moveaxis(a.reshape(a.shape[0], a.shape[1] // Q_BLK, Q_BLK, *a.shape[2:]), 1, 0)


def from_blocks(a):
    a = jnp.moveaxis(a, 0, 1)
    return a.reshape(a.shape[0], a.shape[1] * a.shape[2], *a.shape[3:])


def sq_relu_mlp(h, w_up, w_down):
    return jnp.square(jax.nn.relu(h @ w_up)) @ w_down


def dsa_mixer(h, rel_bias, w_in, g_q_lat, g_kv_lat, g_k_idx, w_uq, w_q_idx, w_uk, w_uv, w_o):
    B, T, _ = h.shape
    top_k = min(IDX_TOPK_MAX, T // 4)
    proj = h @ w_in
    c_q, c_kv, k_idx, w_idx = jnp.split(proj, [Q_LORA, Q_LORA + KV_LORA, Q_LORA + KV_LORA + IDX_DIM], axis=-1)
    c_q = rmsnorm(c_q, g_q_lat)
    c_kv = rmsnorm(c_kv, g_kv_lat)
    k_idx = rmsnorm(k_idx, g_k_idx)
    q = jnp.einsum('btr,rhd->bthd', c_q, w_uq)
    q_abs = jnp.einsum('bthd,chd->bthc', q, w_uk) * HEAD_DIM ** -0.5
    q_idx = jnp.einsum('btr,rhd->bthd', c_q, w_q_idx)
    w_idx = w_idx * (IDX_HEADS ** -0.5 * IDX_DIM ** -0.5)
    key_pos = jnp.arange(T, dtype=jnp.int32)

    def block(args):
        qa, qi, wi, t0 = args
        t = t0 + jnp.arange(Q_BLK, dtype=jnp.int32)
        rel = jax.nn.relu(jnp.einsum('bqhd,bsd->bqhs', qi, k_idx).astype(jnp.float32))
        score = jnp.einsum('bqh,bqhs->bqs', wi.astype(jnp.float32), rel)
        score = jnp.where(key_pos[None, None, :] <= t[None, :, None], score, NEG)
        _, sel = lax.top_k(score, top_k)
        c_sel = jax.vmap(gather_rows)(c_kv, sel)
        dist = t[None, :, None] - sel
        logits = jnp.einsum('bqhc,bqkc->bqhk', qa, c_sel).astype(jnp.float32)
        logits = logits + jnp.transpose(rel_bias[rel_bucket(dist)], (0, 1, 3, 2))
        p = masked_softmax(logits, (dist >= 0)[:, :, None, :])
        return jnp.einsum('bqhk,bqkc->bqhc', p.astype(c_sel.dtype), c_sel)

    t0s = jnp.arange(T // Q_BLK, dtype=jnp.int32) * Q_BLK
    o_lat = from_blocks(lax.map(block, (to_blocks(q_abs), to_blocks(q_idx), to_blocks(w_idx), t0s)))
    o = jnp.einsum('bthc,chd->bthd', o_lat, w_uv).reshape(B, T, N_HEADS * HEAD_DIM)
    return o @ w_o


def compress_blocks(raw, n_cmp, pos, w1, w2):
    B = raw.shape[0]
    idx = CMP_STRIDE * np.arange(n_cmp)[:, None] + np.arange(CMP_LEN)[None, :]
    blocks = raw[:, idx] + pos[None, None, :, None, :]
    flat = jnp.transpose(blocks, (0, 1, 3, 2, 4)).reshape(B, n_cmp, N_KV_GROUPS, CMP_LEN * HEAD_DIM)
    return jax.nn.gelu(flat @ w1) @ w2


def selection_map(n_cmp, n_slc):
    c0 = CMP_STRIDE * np.arange(n_cmp)[:, None]
    s0 = SLC_BLK * np.arange(n_slc)[None, :]
    ov = np.clip(np.minimum(c0 + CMP_LEN, s0 + SLC_BLK) - np.maximum(c0, s0), 0, None)
    return (ov / CMP_LEN).astype(np.float32)


def shared_kv(x, g_kv, w_kv, pos_k, pos_v, w1_k, w2_k, w1_v, w2_v):
    B, T, _ = x.shape
    hs = rmsnorm(x, g_kv)
    kv = (hs @ w_kv).reshape(B, T, 6, N_KV_GROUPS, HEAD_DIM)
    k_cmp, v_cmp, k_slc, v_slc, k_win, v_win = [kv[:, :, i] for i in range(6)]
    n_cmp = (T - CMP_LEN) // CMP_STRIDE + 1
    kc = compress_blocks(k_cmp, n_cmp, pos_k, w1_k, w2_k)
    vc = compress_blocks(v_cmp, n_cmp, pos_v, w1_v, w2_v)
    n_slc = T // SLC_BLK

    def to_sel(a):
        return jnp.transpose(a.reshape(B, n_slc, SLC_BLK, N_KV_GROUPS, HEAD_DIM), (0, 3, 1, 2, 4))

    pad = ((0, 0), (WIN, 0), (0, 0), (0, 0))
    return (kc, vc, to_sel(k_slc), to_sel(v_slc), jnp.pad(k_win, pad), jnp.pad(v_win, pad))


def nsa_mixer(h, rel_bias, kv_shared, w_in, w_o):
    kc, vc, ks_blk, vs_blk, kw_pad, vw_pad = kv_shared
    B, T, _ = h.shape
    G, R = N_KV_GROUPS, HEADS_PER_GROUP
    n_cmp = kc.shape[1]
    n_slc = ks_blk.shape[2]
    n_sel = min(N_SLC_MAX, n_slc)
    cmp_end = jnp.asarray(CMP_STRIDE * np.arange(n_cmp) + CMP_LEN - 1, dtype=jnp.int32)
    sel_map = jnp.asarray(selection_map(n_cmp, n_slc))
    blk_ids = jnp.arange(n_slc, dtype=jnp.int32)
    bias_gr = rel_bias.reshape(REL_BUCKETS, G, R)
    g_ids = jnp.arange(G, dtype=jnp.int32)[None, None, :, None]
    gather_groups = jax.vmap(jax.vmap(gather_rows, in_axes=(0, 1), out_axes=1))

    proj = h @ w_in
    q = proj[..., :N_HEADS * HEAD_DIM].reshape(B, T, G, R, HEAD_DIM) * HEAD_DIM ** -0.5
    gates = jax.nn.sigmoid(proj[..., N_HEADS * HEAD_DIM:].astype(jnp.float32)).astype(h.dtype).reshape(B, T, G, R, 3)

    def block(args):
        qb, gb, t0 = args
        t = t0 + jnp.arange(Q_BLK, dtype=jnp.int32)
        lc = jnp.einsum('bqgrd,bngd->bqgrn', qb, kc).astype(jnp.float32)
        pc = masked_softmax(lc, (cmp_end[None, :] <= t[:, None])[None, :, None, None, :])
        o_cmp = jnp.einsum('bqgrn,bngd->bqgrd', pc.astype(vc.dtype), vc)
        imp = jnp.einsum('bqgrn,nj->bqgj', pc, sel_map)
        cur = t[:, None] // SLC_BLK
        forced = (blk_ids[None, :] == 0) | (blk_ids[None, :] == cur) | (blk_ids[None, :] == cur - 1)
        future = blk_ids[None, :] * SLC_BLK > t[:, None]
        imp = jnp.where(forced[None, :, None, :], 1e9, imp)
        imp = jnp.where(future[None, :, None, :], NEG, imp)
        _, sel = lax.top_k(imp, n_sel)
        k_sel = gather_groups(ks_blk, sel).reshape(B, Q_BLK, G, n_sel * SLC_BLK, HEAD_DIM)
        v_sel = gather_groups(vs_blk, sel).reshape(B, Q_BLK, G, n_sel * SLC_BLK, HEAD_DIM)
        pos = (sel[..., None] * SLC_BLK + jnp.arange(SLC_BLK, dtype=jnp.int32)).reshape(B, Q_BLK, G, n_sel * SLC_BLK)
        dist_s = t[None, :, None, None] - pos
        bias_s = jnp.moveaxis(bias_gr[rel_bucket(dist_s), g_ids], -1, 3)
        ls = jnp.einsum('bqgrd,bqgkd->bqgrk', qb, k_sel).astype(jnp.float32) + bias_s
        ps = masked_softmax(ls, (dist_s >= 0)[:, :, :, None, :])
        o_slc = jnp.einsum('bqgrk,bqgkd->bqgrd', ps.astype(v_sel.dtype), v_sel)
        kw = lax.dynamic_slice_in_dim(kw_pad, t0, WIN + Q_BLK, axis=1)
        vw = lax.dynamic_slice_in_dim(vw_pad, t0, WIN + Q_BLK, axis=1)
        s_w = t0 - WIN + jnp.arange(WIN + Q_BLK, dtype=jnp.int32)
        dist_w = t[:, None] - s_w[None, :]
        wmask = (dist_w >= 0) & (dist_w < WIN) & (s_w[None, :] >= 0)
        bias_w = jnp.transpose(rel_bias[rel_bucket(dist_w)].reshape(Q_BLK, WIN + Q_BLK, G, R), (0, 2, 3, 1))
        lw = jnp.einsum('bqgrd,bsgd->bqgrs', qb, kw).astype(jnp.float32) + bias_w[None]
        pw = masked_softmax(lw, wmask[None, :, None, None, :])
        o_win = jnp.einsum('bqgrs,bsgd->bqgrd', pw.astype(vw.dtype), vw)
        return gb[..., 0:1] * o_cmp + gb[..., 1:2] * o_slc + gb[..., 2:3] * o_win

    t0s = jnp.arange(T // Q_BLK, dtype=jnp.int32) * Q_BLK
    o = from_blocks(lax.map(block, (to_blocks(q), to_blocks(gates), t0s)))
    return o.reshape(B, T, N_HEADS * HEAD_DIM) @ w_o


def setup_inputs(seed: int = 0) -> dict:
    key = jax.random.key(seed)
    ks = jax.random.split(key, 27)

    def nrm(k, shape, scale):
        return jax.random.normal(k, shape, jnp.float32) * scale

    def gain(k, shape):
        return 1.0 + 0.01 * jax.random.normal(k, shape, jnp.float32)

    hd = N_HEADS * HEAD_DIM
    return {
        'x': nrm(ks[0], (BATCH, SEQ, D_MODEL), 1.0),
        'g_attn': gain(ks[1], (DEPTH, D_MODEL)),
        'g_mlp': gain(ks[2], (DEPTH, D_MODEL)),
        'w_up': nrm(ks[3], (DEPTH, D_MODEL, D_FF), D_MODEL ** -0.5),
        'w_down': nrm(ks[4], (DEPTH, D_FF, D_MODEL), D_FF ** -0.5),
        'rel_bias': nrm(ks[5], (REL_BUCKETS, N_HEADS), 0.5),
        'a_w_in': nrm(ks[6], (N_A_LAYERS, D_MODEL, Q_LORA + KV_LORA + IDX_DIM + IDX_HEADS), D_MODEL ** -0.5),
        'a_g_q_lat': gain(ks[7], (N_A_LAYERS, Q_LORA)),
        'a_g_kv_lat': gain(ks[8], (N_A_LAYERS, KV_LORA)),
        'a_g_k_idx': gain(ks[9], (N_A_LAYERS, IDX_DIM)),
        'a_w_uq': nrm(ks[10], (N_A_LAYERS, Q_LORA, N_HEADS, HEAD_DIM), Q_LORA ** -0.5),
        'a_w_q_idx': nrm(ks[11], (N_A_LAYERS, Q_LORA, IDX_HEADS, IDX_DIM), Q_LORA ** -0.5),
        'a_w_uk': nrm(ks[12], (N_A_LAYERS, KV_LORA, N_HEADS, HEAD_DIM), KV_LORA ** -0.5),
        'a_w_uv': nrm(ks[13], (N_A_LAYERS, KV_LORA, N_HEADS, HEAD_DIM), KV_LORA ** -0.5),
        'a_w_o': nrm(ks[14], (N_A_LAYERS, hd, D_MODEL), hd ** -0.5),
        'g_kv_shared': gain(ks[15], (D_MODEL,)),
        'w_kv_shared': nrm(ks[16], (D_MODEL, 6 * N_KV_GROUPS * HEAD_DIM), D_MODEL ** -0.5),
        'cmp_pos_k': nrm(ks[17], (CMP_LEN, HEAD_DIM), 0.5),
        'cmp_pos_v': nrm(ks[18], (CMP_LEN, HEAD_DIM), 0.5),
        'cmp_w1_k': nrm(ks[19], (CMP_LEN * HEAD_DIM, CMP_HID), (CMP_LEN * HEAD_DIM) ** -0.5),
        'cmp_w2_k': nrm(ks[20], (CMP_HID, HEAD_DIM), CMP_HID ** -0.5),
        'cmp_w1_v': nrm(ks[21], (CMP_LEN * HEAD_DIM, CMP_HID), (CMP_LEN * HEAD_DIM) ** -0.5),
        'cmp_w2_v': nrm(ks[22], (CMP_HID, HEAD_DIM), CMP_HID ** -0.5),
        'b_w_in': nrm(ks[23], (N_B_LAYERS, D_MODEL, hd + 3 * N_HEADS), D_MODEL ** -0.5),
        'b_w_o': nrm(ks[24], (N_B_LAYERS, hd, D_MODEL), hd ** -0.5),
        'g_final': gain(ks[25], (D_MODEL,)),
    }


def reference(x, g_attn, g_mlp, w_up, w_down, rel_bias, a_w_in, a_g_q_lat, a_g_kv_lat, a_g_k_idx,
              a_w_uq, a_w_q_idx, a_w_uk, a_w_uv, a_w_o, g_kv_shared, w_kv_shared, cmp_pos_k, cmp_pos_v,
              cmp_w1_k, cmp_w2_k, cmp_w1_v, cmp_w2_v, b_w_in, b_w_o, g_final):
    kv_shared = None
    for l in range(DEPTH):
        h = rmsnorm(x, g_attn[l])
        if l < N_A_LAYERS:
            x = x + dsa_mixer(h, rel_bias, a_w_in[l], a_g_q_lat[l], a_g_kv_lat[l], a_g_k_idx[l],
                              a_w_uq[l], a_w_q_idx[l], a_w_uk[l], a_w_uv[l], a_w_o[l])
        else:
            j = l - N_A_LAYERS
            x = x + nsa_mixer(h, rel_bias, kv_shared, b_w_in[j], b_w_o[j])
        x = x + sq_relu_mlp(rmsnorm(x, g_mlp[l]), w_up[l], w_down[l])
        if l == N_A_LAYERS - 1:
            kv_shared = shared_kv(x, g_kv_shared, w_kv_shared, cmp_pos_k, cmp_pos_v,
                                  cmp_w1_k, cmp_w2_k, cmp_w1_v, cmp_w2_v)
    return rmsnorm(x, g_final)
```

```cpp
#include <hip/hip_runtime.h>
#include <stdint.h>
#include <cstdio>

namespace nv {
constexpr int Bn = 4, T = 8192, D = 1024, M = Bn * T, FF = 4096;
constexpr int PW = 456;
constexpr int KVW = 1536;
constexpr int QPW = 1048;
constexpr int NCMP = 511;
constexpr float NEGF = -1e30f;
constexpr size_t MiB = 1u << 20;

__device__ __forceinline__ float wave_sum(float v) {
#pragma unroll
    for (int o = 1; o < 64; o <<= 1) v += __shfl_xor(v, o);
    return v;
}
__device__ __forceinline__ float wave_max(float v) {
#pragma unroll
    for (int o = 1; o < 64; o <<= 1) v = fmaxf(v, __shfl_xor(v, o));
    return v;
}
__device__ __forceinline__ float block_sum(float v, float* red) {
    v = wave_sum(v);
    __syncthreads();
    if ((threadIdx.x & 63) == 0) red[threadIdx.x >> 6] = v;
    __syncthreads();
    return (red[0] + red[1]) + (red[2] + red[3]);
}
__device__ __forceinline__ float block_max(float v, float* red) {
    v = wave_max(v);
    __syncthreads();
    if ((threadIdx.x & 63) == 0) red[threadIdx.x >> 6] = v;
    __syncthreads();
    return fmaxf(fmaxf(red[0], red[1]), fmaxf(red[2], red[3]));
}
__device__ __forceinline__ int rel_bucket(int dist) {
    if (dist < 16) return dist < 0 ? 0 : dist;
    int v = 39 - __clz(dist * dist);
    return v > 31 ? 31 : v;
}

__global__ __launch_bounds__(256) void rmsnorm_k(const float* x, const float* g, float* y, int rows) {
    int row = blockIdx.x * 4 + (threadIdx.x >> 6), lane = threadIdx.x & 63;
    if (row >= rows) return;
    const float4* xr = (const float4*)(x + (size_t)row * D);
    float4 v[4]; float s = 0.f;
#pragma unroll
    for (int j = 0; j < 4; ++j) { v[j] = xr[lane + 64 * j]; s += v[j].x * v[j].x + v[j].y * v[j].y + v[j].z * v[j].z + v[j].w * v[j].w; }
    s = wave_sum(s);
    float r = 1.0f / sqrtf(s * (1.0f / D) + 1e-6f);
    float4* yr = (float4*)(y + (size_t)row * D);
    const float4* gr = (const float4*)g;
#pragma unroll
    for (int j = 0; j < 4; ++j) { float4 gg = gr[lane + 64 * j]; float4 o; o.x = v[j].x * r * gg.x; o.y = v[j].y * r * gg.y; o.z = v[j].z * r * gg.z; o.w = v[j].w * r * gg.w; yr[lane + 64 * j] = o; }
}

template <int EPI>
__global__ __launch_bounds__(256) void gemm_nv(const float* __restrict__ A, long lda, const float* __restrict__ Bm, long sbk, long sbn,
                                               float* C, long ldc, int Mr, int N, int K, const float* R, long ldr, const float* bias, float scale) {
    __shared__ float As[16][68], Bs[16][68];
    const int tx = threadIdx.x & 15, ty = threadIdx.x >> 4;
    const int m0 = blockIdx.y * 64, n0 = blockIdx.x * 64;
    float acc[4][4];
#pragma unroll
    for (int i = 0; i < 4; ++i)
#pragma unroll
        for (int j = 0; j < 4; ++j) acc[i][j] = 0.f;
    for (int k0 = 0; k0 < K; k0 += 16) {
#pragma unroll
        for (int i = 0; i < 4; ++i) { int idx = threadIdx.x + 256 * i; int r = idx >> 4, kk = idx & 15; int m = m0 + r; As[kk][r] = (m < Mr) ? A[(long)m * lda + k0 + kk] : 0.f; }
#pragma unroll
        for (int i = 0; i < 4; ++i) { int idx = threadIdx.x + 256 * i; int kk = idx >> 6, c = idx & 63; int n = n0 + c; Bs[kk][c] = (n < N) ? Bm[(long)(k0 + kk) * sbk + (long)n * sbn] : 0.f; }
        __syncthreads();
#pragma unroll
        for (int kk = 0; kk < 16; ++kk) {
            float a[4], b[4];
#pragma unroll
            for (int i = 0; i < 4; ++i) { a[i] = As[kk][ty * 4 + i]; b[i] = Bs[kk][tx * 4 + i]; }
#pragma unroll
            for (int i = 0; i < 4; ++i)
#pragma unroll
                for (int j = 0; j < 4; ++j) acc[i][j] += a[i] * b[j];
        }
        __syncthreads();
    }
#pragma unroll
    for (int i = 0; i < 4; ++i) {
        int m = m0 + ty * 4 + i; if (m >= Mr) continue;
#pragma unroll
        for (int j = 0; j < 4; ++j) {
            int n = n0 + tx * 4 + j; if (n >= N) continue;
            float v = acc[i][j];
            if (EPI == 0) v = v * scale;
            else if (EPI == 1) v = R[(long)m * ldr + n] + v;
            else if (EPI == 2) { v = fmaxf(v, 0.f); v = v * v; }
            else if (EPI == 3) { if (n < 1024) v = v * scale; else v = 1.0f / (1.0f + expf(-v)); }
            else if (EPI == 4) { v += bias[n]; float u = 0.7978845608028654f * (v + 0.044715f * v * v * v); v = 0.5f * v * (1.0f + tanhf(u)); }
            C[(long)m * ldc + n] = v;
        }
    }
}

__global__ __launch_bounds__(256) void dsa_prep_k(float* PROJ, const float* gq, const float* gkv, const float* gk) {
    int row = blockIdx.x * 4 + (threadIdx.x >> 6), lane = threadIdx.x & 63;
    float* p = PROJ + (size_t)row * PW;
    float v0[4]; float s = 0.f;
#pragma unroll
    for (int j = 0; j < 4; ++j) { v0[j] = p[lane + 64 * j]; s += v0[j] * v0[j]; }
    s = wave_sum(s); float r = 1.0f / sqrtf(s * (1.0f / 256) + 1e-6f);
#pragma unroll
    for (int j = 0; j < 4; ++j) p[lane + 64 * j] = v0[j] * r * gq[lane + 64 * j];
    float a0 = p[256 + lane], a1 = p[320 + lane];
    s = wave_sum(a0 * a0 + a1 * a1); r = 1.0f / sqrtf(s * (1.0f / 128) + 1e-6f);
    p[256 + lane] = a0 * r * gkv[lane]; p[320 + lane] = a1 * r * gkv[64 + lane];
    float k = p[384 + lane];
    s = wave_sum(k * k); r = 1.0f / sqrtf(s * (1.0f / 64) + 1e-6f);
    p[384 + lane] = k * r * gk[lane];
    if (lane < 8) p[448 + lane] *= 0.04419417382415922f;
}

__device__ __forceinline__ unsigned f2key(float f) { unsigned u = __float_as_uint(f); return (u & 0x80000000u) ? ~u : (u | 0x80000000u); }

__global__ __launch_bounds__(256) void dsa_index_nv(const float* PROJ, const float* QIDX, int* SEL) {
    __shared__ float qs[512]; __shared__ float wsh[8]; __shared__ unsigned sc[8192]; __shared__ unsigned hist[256];
    __shared__ int sh_bin, sh_k; __shared__ unsigned sh_cnt; __shared__ int wtot[4];
    const int m = blockIdx.x, b = m >> 13, t = m & 8191, tid = threadIdx.x;
    qs[tid] = QIDX[(size_t)m * 512 + tid]; qs[tid + 256] = QIDX[(size_t)m * 512 + 256 + tid];
    if (tid < 8) wsh[tid] = PROJ[(size_t)m * PW + 448 + tid];
    if (tid == 0) sh_cnt = 0;
    __syncthreads();
    const int n = t + 1;
    int* out = SEL + (size_t)m * 256;
    if (n <= 256) { out[tid] = tid < n ? tid : -1; return; }
    for (int s = tid; s < n; s += 256) {
        const float* kr = PROJ + (size_t)(b * T + s) * PW + 384;
        float a[8];
#pragma unroll
        for (int h = 0; h < 8; ++h) a[h] = 0.f;
#pragma unroll 1
        for (int d = 0; d < 64; d += 4) {
            float4 kv = *(const float4*)(kr + d);
#pragma unroll
            for (int h = 0; h < 8; ++h) a[h] += qs[h * 64 + d] * kv.x + qs[h * 64 + d + 1] * kv.y + qs[h * 64 + d + 2] * kv.z + qs[h * 64 + d + 3] * kv.w;
        }
        float scv = 0.f;
#pragma unroll
        for (int h = 0; h < 8; ++h) scv += wsh[h] * fmaxf(a[h], 0.f);
        sc[s] = f2key(scv);
    }
    __syncthreads();
    unsigned prefix = 0, mask = 0; int k = 256;
    for (int pass = 3; pass >= 0; --pass) {
        hist[tid] = 0; __syncthreads();
        for (int s = tid; s < n; s += 256) { unsigned u = sc[s]; if ((u & mask) == prefix) atomicAdd(&hist[(u >> (8 * pass)) & 255], 1u); }
        __syncthreads();
        if (tid == 0) { int cum = 0, bin = 255; for (; bin > 0; --bin) { int c = (int)hist[bin]; if (cum + c >= k) break; cum += c; } sh_bin = bin; sh_k = k - cum; }
        __syncthreads();
        prefix |= (unsigned)sh_bin << (8 * pass); mask |= 0xFFu << (8 * pass); k = sh_k;
        __syncthreads();
    }
    const unsigned thr = prefix; const int ngt = 256 - k;
    for (int s = tid; s < n; s += 256) if (sc[s] > thr) { unsigned p = atomicAdd(&sh_cnt, 1u); out[p] = s; }
    int running = 0;
    for (int s0 = 0; s0 < n && running < k; s0 += 256) {
        int s = s0 + tid; bool e = (s < n) && (sc[s] == thr);
        unsigned long long bal = __ballot(e);
        int lane = tid & 63, w = tid >> 6;
        int pre = __popcll(bal & ((1ull << lane) - 1ull));
        if (lane == 0) wtot[w] = __popcll(bal);
        __syncthreads();
        int woff = 0; for (int i = 0; i < w; ++i) woff += wtot[i];
        int tot = wtot[0] + wtot[1] + wtot[2] + wtot[3];
        int pos = running + woff + pre;
        if (e && pos < k) out[ngt + pos] = s;
        running += tot;
        __syncthreads();
    }
}

__global__ __launch_bounds__(256) void dsa_attn_nv(const float* PROJ, const float* QABS, const int* SEL, const float* rel_bias, float* OLAT) {
    __shared__ float qa[1024]; __shared__ float p[8][256]; __shared__ int ssel[256]; __shared__ float red[4];
    const int m = blockIdx.x, b = m >> 13, t = m & 8191, tid = threadIdx.x;
#pragma unroll
    for (int i = 0; i < 4; ++i) qa[tid + 256 * i] = QABS[(size_t)m * 1024 + tid + 256 * i];
    int s = SEL[(size_t)m * 256 + tid];
    bool valid = (s >= 0) && (s <= t);
    ssel[tid] = valid ? s : -1;
    __syncthreads();
    float lg[8];
#pragma unroll
    for (int h = 0; h < 8; ++h) lg[h] = 0.f;
    if (valid) {
        const float* kr = PROJ + (size_t)(b * T + s) * PW + 256;
#pragma unroll 1
        for (int d = 0; d < 128; d += 4) {
            float4 c = *(const float4*)(kr + d);
#pragma unroll
            for (int h = 0; h < 8; ++h) lg[h] += qa[h * 128 + d] * c.x + qa[h * 128 + d + 1] * c.y + qa[h * 128 + d + 2] * c.z + qa[h * 128 + d + 3] * c.w;
        }
        int bk = rel_bucket(t - s);
#pragma unroll
        for (int h = 0; h < 8; ++h) lg[h] += rel_bias[bk * 8 + h];
    }
#pragma unroll
    for (int h = 0; h < 8; ++h) {
        float mx = block_max(valid ? lg[h] : NEGF, red);
        float e = valid ? expf(lg[h] - mx) : 0.f;
        float sm = block_sum(e, red);
        p[h][tid] = e / fmaxf(sm, 1e-30f);
    }
    __syncthreads();
    const int h = tid >> 5, c4 = (tid & 31) * 4;
    float4 acc = {0.f, 0.f, 0.f, 0.f};
    for (int k = 0; k < 256; ++k) {
        int sk = ssel[k]; if (sk < 0) continue;
        float4 c = *(const float4*)(PROJ + (size_t)(b * T + sk) * PW + 256 + c4);
        float ph = p[h][k];
        acc.x += ph * c.x; acc.y += ph * c.y; acc.z += ph * c.z; acc.w += ph * c.w;
    }
    *(float4*)(OLAT + (size_t)m * 1024 + h * 128 + c4) = acc;
}

__global__ __launch_bounds__(256) void cmp_gather_k(const float* KV, const float* pos, float* FLAT, int part) {
    int row = blockIdx.x; int g = row & 1, bn = row >> 1, n = bn % NCMP, b = bn / NCMP;
    for (int i = threadIdx.x; i < 4096; i += 256) { int j = i >> 7, d = i & 127; FLAT[(size_t)row * 4096 + i] = KV[(size_t)(b * T + 16 * n + j) * KVW + part * 256 + g * 128 + d] + pos[i]; }
}

__global__ __launch_bounds__(256) void nsa_attn_nv(const float* QP, const float* KV, const float* KC, const float* VC, const float* rel_bias, float* O) {
    __shared__ float q[1024]; __shared__ float lg[8][1024]; __shared__ float impS[2][128]; __shared__ int selS[2][16]; __shared__ float red[4];
    const int m = blockIdx.x, b = m >> 13, t = m & 8191, tid = threadIdx.x;
#pragma unroll
    for (int i = 0; i < 4; ++i) q[tid + 256 * i] = QP[(size_t)m * QPW + tid + 256 * i];
    __syncthreads();
    const int h = tid >> 5, d4 = (tid & 31) * 4, gh = h >> 2;
    const int nvld = t < 31 ? 0 : (t - 31) / 16 + 1;
    for (int n = tid; n < nvld; n += 256) {
#pragma unroll
        for (int g = 0; g < 2; ++g) {
            const float* kr = KC + ((size_t)(b * NCMP + n) * 2 + g) * 128;
            float a[4] = {0.f, 0.f, 0.f, 0.f};
    #pragma unroll 1
        for (int d = 0; d < 128; d += 4) {
                float4 c = *(const float4*)(kr + d);
#pragma unroll
                for (int r = 0; r < 4; ++r) { const float* qq = q + (g * 4 + r) * 128 + d; a[r] += qq[0] * c.x + qq[1] * c.y + qq[2] * c.z + qq[3] * c.w; }
            }
#pragma unroll
            for (int r = 0; r < 4; ++r) lg[g * 4 + r][n] = a[r];
        }
    }
    __syncthreads();
    for (int hh = 0; hh < 8; ++hh) {
        float mx = NEGF;
        for (int n = tid; n < nvld; n += 256) mx = fmaxf(mx, lg[hh][n]);
        mx = block_max(mx, red);
        float sm = 0.f;
        for (int n = tid; n < nvld; n += 256) { float e = expf(lg[hh][n] - mx); lg[hh][n] = e; sm += e; }
        sm = block_sum(sm, red);
        float inv = 1.0f / fmaxf(sm, 1e-30f);
        for (int n = tid; n < nvld; n += 256) lg[hh][n] *= inv;
    }
    __syncthreads();
    float4 ocmp = {0.f, 0.f, 0.f, 0.f};
    for (int n = 0; n < nvld; ++n) {
        float4 v = *(const float4*)(VC + ((size_t)(b * NCMP + n) * 2 + gh) * 128 + d4);
        float ph = lg[h][n];
        ocmp.x += ph * v.x; ocmp.y += ph * v.y; ocmp.z += ph * v.z; ocmp.w += ph * v.w;
    }
    {
        const int g = tid >> 7, j = tid & 127;
        float imp = 0.f;
#pragma unroll
        for (int dn = -1; dn <= 3; ++dn) {
            int n = 4 * j + dn;
            if (n >= 0 && n < nvld) { float P = lg[g * 4 + 0][n] + lg[g * 4 + 1][n] + lg[g * 4 + 2][n] + lg[g * 4 + 3][n]; imp += (dn == -1 || dn == 3) ? 0.5f * P : P; }
        }
        const int cur = t >> 6;
        if (j == 0 || j == cur || j == cur - 1) imp = 1e9f;
        if (j * 64 > t) imp = NEGF;
        impS[g][j] = imp;
        __syncthreads();
        int rank = 0;
        for (int jj = 0; jj < 128; ++jj) { float o = impS[g][jj]; rank += (o > imp || (o == imp && jj < j)) ? 1 : 0; }
        if (rank < 16) selS[g][rank] = j;
    }
    __syncthreads();
    for (int g = 0; g < 2; ++g) {
        for (int kk = tid; kk < 1024; kk += 256) {
            int pos = selS[g][kk >> 6] * 64 + (kk & 63); int dist = t - pos;
            if (dist >= 0) {
                const float* kr = KV + (size_t)(b * T + pos) * KVW + 2 * 256 + g * 128;
                float a[4] = {0.f, 0.f, 0.f, 0.f};
        #pragma unroll 1
        for (int d = 0; d < 128; d += 4) {
                    float4 c = *(const float4*)(kr + d);
#pragma unroll
                    for (int r = 0; r < 4; ++r) { const float* qq = q + (g * 4 + r) * 128 + d; a[r] += qq[0] * c.x + qq[1] * c.y + qq[2] * c.z + qq[3] * c.w; }
                }
                int bk = rel_bucket(dist);
#pragma unroll
                for (int r = 0; r < 4; ++r) lg[g * 4 + r][kk] = a[r] + rel_bias[bk * 8 + g * 4 + r];
            } else {
#pragma unroll
                for (int r = 0; r < 4; ++r) lg[g * 4 + r][kk] = NEGF;
            }
        }
    }
    __syncthreads();
    for (int hh = 0; hh < 8; ++hh) {
        float mx = NEGF;
        for (int n = tid; n < 1024; n += 256) mx = fmaxf(mx, lg[hh][n]);
        mx = block_max(mx, red);
        float sm = 0.f;
        for (int n = tid; n < 1024; n += 256) { float x = lg[hh][n]; float e = (x > -1e29f) ? expf(x - mx) : 0.f; lg[hh][n] = e; sm += e; }
        sm = block_sum(sm, red);
        float inv = 1.0f / fmaxf(sm, 1e-30f);
        for (int n = tid; n < 1024; n += 256) lg[hh][n] *= inv;
    }
    __syncthreads();
    float4 oslc = {0.f, 0.f, 0.f, 0.f};
    for (int kk = 0; kk < 1024; ++kk) {
        float ph = lg[h][kk]; if (ph == 0.f) continue;
        int pos = selS[gh][kk >> 6] * 64 + (kk & 63);
        float4 v = *(const float4*)(KV + (size_t)(b * T + pos) * KVW + 3 * 256 + gh * 128 + d4);
        oslc.x += ph * v.x; oslc.y += ph * v.y; oslc.z += ph * v.z; oslc.w += ph * v.w;
    }
    __syncthreads();
    for (int kk = tid; kk < 512; kk += 256) {
        int s = t - 511 + kk; int dist = 511 - kk;
        if (s >= 0) {
            int bk = rel_bucket(dist);
#pragma unroll
            for (int g = 0; g < 2; ++g) {
                const float* kr = KV + (size_t)(b * T + s) * KVW + 4 * 256 + g * 128;
                float a[4] = {0.f, 0.f, 0.f, 0.f};
        #pragma unroll 1
        for (int d = 0; d < 128; d += 4) {
                    float4 c = *(const float4*)(kr + d);
#pragma unroll
                    for (int r = 0; r < 4; ++r) { const float* qq = q + (g * 4 + r) * 128 + d; a[r] += qq[0] * c.x + qq[1] * c.y + qq[2] * c.z + qq[3] * c.w; }
                }
#pragma unroll
                for (int r = 0; r < 4; ++r) lg[g * 4 + r][kk] = a[r] + rel_bias[bk * 8 + g * 4 + r];
            }
        } else {
#pragma unroll
            for (int hh = 0; hh < 8; ++hh) lg[hh][kk] = NEGF;
        }
    }
    __syncthreads();
    for (int hh = 0; hh < 8; ++hh) {
        float mx = NEGF;
        for (int n = tid; n < 512; n += 256) mx = fmaxf(mx, lg[hh][n]);
        mx = block_max(mx, red);
        float sm = 0.f;
        for (int n = tid; n < 512; n += 256) { float x = lg[hh][n]; float e = (x > -1e29f) ? expf(x - mx) : 0.f; lg[hh][n] = e; sm += e; }
        sm = block_sum(sm, red);
        float inv = 1.0f / fmaxf(sm, 1e-30f);
        for (int n = tid; n < 512; n += 256) lg[hh][n] *= inv;
    }
    __syncthreads();
    float4 owin = {0.f, 0.f, 0.f, 0.f};
    for (int kk = 0; kk < 512; ++kk) {
        float ph = lg[h][kk]; if (ph == 0.f) continue;
        int s = t - 511 + kk;
        float4 v = *(const float4*)(KV + (size_t)(b * T + s) * KVW + 5 * 256 + gh * 128 + d4);
        owin.x += ph * v.x; owin.y += ph * v.y; owin.z += ph * v.z; owin.w += ph * v.w;
    }
    const float g0 = QP[(size_t)m * QPW + 1024 + h * 3 + 0], g1 = QP[(size_t)m * QPW + 1024 + h * 3 + 1], g2 = QP[(size_t)m * QPW + 1024 + h * 3 + 2];
    float4 o;
    o.x = g0 * ocmp.x + g1 * oslc.x + g2 * owin.x; o.y = g0 * ocmp.y + g1 * oslc.y + g2 * owin.y;
    o.z = g0 * ocmp.z + g1 * oslc.z + g2 * owin.z; o.w = g0 * ocmp.w + g1 * oslc.w + g2 * owin.w;
    *(float4*)(O + (size_t)m * 1024 + h * 128 + d4) = o;
}

template <int EPI>
static void gemm(hipStream_t st, const float* A, long lda, const float* Bm, long sbk, long sbn, float* C, long ldc, int Mr, int N, int K,
                 const float* R = nullptr, long ldr = 0, const float* bias = nullptr, float scale = 1.f) {
    dim3 grid((N + 63) / 64, (Mr + 63) / 64);
    hipLaunchKernelGGL(gemm_nv<EPI>, grid, dim3(256), 0, st, A, lda, Bm, sbk, sbn, C, ldc, Mr, N, K, R, ldr, bias, scale);
}

static void mlp(hipStream_t st, float* Rs, float* H, float* U, const float* g, const float* wup, const float* wdown) {
    hipLaunchKernelGGL(rmsnorm_k, dim3(M / 4), dim3(256), 0, st, (const float*)Rs, g, H, M);
    for (int c = 0; c < 8; ++c) {
        const float* Hc = H + (size_t)c * 4096 * D; float* Rc = Rs + (size_t)c * 4096 * D;
        gemm<2>(st, Hc, D, wup, FF, 1, U, FF, 4096, FF, D);
        gemm<1>(st, U, FF, wdown, D, 1, Rc, D, 4096, D, FF, Rc, D);
    }
}

static void forward(void* const* d_in, float* out, unsigned char* ws, hipStream_t st) {
    const float* x = (const float*)d_in[0]; const float* g_attn = (const float*)d_in[1]; const float* g_mlp = (const float*)d_in[2];
    const float* w_up = (const float*)d_in[3]; const float* w_down = (const float*)d_in[4]; const float* rel_bias = (const float*)d_in[5];
    const float* a_w_in = (const float*)d_in[6]; const float* a_gq = (const float*)d_in[7]; const float* a_gkv = (const float*)d_in[8]; const float* a_gk = (const float*)d_in[9];
    const float* a_w_uq = (const float*)d_in[10]; const float* a_w_qidx = (const float*)d_in[11]; const float* a_w_uk = (const float*)d_in[12]; const float* a_w_uv = (const float*)d_in[13];
    const float* a_w_o = (const float*)d_in[14]; const float* g_kv = (const float*)d_in[15]; const float* w_kv = (const float*)d_in[16];
    const float* pos_k = (const float*)d_in[17]; const float* pos_v = (const float*)d_in[18];
    const float* w1k = (const float*)d_in[19]; const float* w2k = (const float*)d_in[20]; const float* w1v = (const float*)d_in[21]; const float* w2v = (const float*)d_in[22];
    const float* b_w_in = (const float*)d_in[23]; const float* b_w_o = (const float*)d_in[24]; const float* g_final = (const float*)d_in[25];
    float* R = out;
    float* H = (float*)(ws + 0 * MiB);
    float* PROJ = (float*)(ws + 128 * MiB);
    float* Q = (float*)(ws + 0 * MiB);
    float* QABS = (float*)(ws + 192 * MiB);
    float* QIDX = (float*)(ws + 320 * MiB);
    int* SEL = (int*)(ws + 384 * MiB);
    float* OLAT = (float*)(ws + 0 * MiB);
    float* O2 = (float*)(ws + 192 * MiB);
    float* U = (float*)(ws + 192 * MiB);
    hipLaunchKernelGGL(rmsnorm_k, dim3(M / 4), dim3(256), 0, st, x, g_attn, H, M);
    gemm<0>(st, H, D, a_w_in, PW, 1, PROJ, PW, M, PW, D);
    hipLaunchKernelGGL(dsa_prep_k, dim3(M / 4), dim3(256), 0, st, PROJ, a_gq, a_gkv, a_gk);
    gemm<0>(st, PROJ, PW, a_w_uq, 1024, 1, Q, 1024, M, 1024, 256);
    for (int h = 0; h < 8; ++h) gemm<0>(st, Q + h * 128, 1024, a_w_uk + h * 128, 1, 1024, QABS + h * 128, 1024, M, 128, 128, nullptr, 0, nullptr, 0.08838834764831845f);
    gemm<0>(st, PROJ, PW, a_w_qidx, 512, 1, QIDX, 512, M, 512, 256);
    hipLaunchKernelGGL(dsa_index_nv, dim3(M), dim3(256), 0, st, (const float*)PROJ, (const float*)QIDX, SEL);
    hipLaunchKernelGGL(dsa_attn_nv, dim3(M), dim3(256), 0, st, (const float*)PROJ, (const float*)QABS, (const int*)SEL, rel_bias, OLAT);
    for (int h = 0; h < 8; ++h) gemm<0>(st, OLAT + h * 128, 1024, a_w_uv + h * 128, 1024, 1, O2 + h * 128, 1024, M, 128, 128);
    gemm<1>(st, O2, 1024, a_w_o, 1024, 1, R, 1024, M, 1024, 1024, x, 1024);
    mlp(st, R, H, U, g_mlp, w_up, w_down);
    float* KV = (float*)(ws + 128 * MiB);
    float* FLAT = (float*)(ws + 320 * MiB);
    float* HID = (float*)(ws + 384 * MiB);
    float* KC = (float*)(ws + 460 * MiB);
    float* VC = (float*)(ws + 464 * MiB);
    float* BIAS0 = (float*)(ws + 468 * MiB);
    hipMemsetAsync(BIAS0, 0, 1024, st);
    hipLaunchKernelGGL(rmsnorm_k, dim3(M / 4), dim3(256), 0, st, (const float*)R, g_kv, H, M);
    gemm<0>(st, H, D, w_kv, KVW, 1, KV, KVW, M, KVW, D);
    const int NR = Bn * NCMP * 2;
    hipLaunchKernelGGL(cmp_gather_k, dim3(NR), dim3(256), 0, st, (const float*)KV, pos_k, FLAT, 0);
    gemm<4>(st, FLAT, 4096, w1k, 256, 1, HID, 256, NR, 256, 4096, nullptr, 0, BIAS0);
    gemm<0>(st, HID, 256, w2k, 128, 1, KC, 128, NR, 128, 256);
    hipLaunchKernelGGL(cmp_gather_k, dim3(NR), dim3(256), 0, st, (const float*)KV, pos_v, FLAT, 1);
    gemm<4>(st, FLAT, 4096, w1v, 256, 1, HID, 256, NR, 256, 4096, nullptr, 0, BIAS0);
    gemm<0>(st, HID, 256, w2v, 128, 1, VC, 128, NR, 128, 256);
    float* QP = (float*)(ws + 320 * MiB);
    float* O = (float*)(ws + 0 * MiB);
    hipLaunchKernelGGL(rmsnorm_k, dim3(M / 4), dim3(256), 0, st, (const float*)R, g_attn + D, H, M);
    gemm<3>(st, H, D, b_w_in, QPW, 1, QP, QPW, M, QPW, D, nullptr, 0, nullptr, 0.08838834764831845f);
    hipLaunchKernelGGL(nsa_attn_nv, dim3(M), dim3(256), 0, st, (const float*)QP, (const float*)KV, (const float*)KC, (const float*)VC, rel_bias, O);
    gemm<1>(st, O, 1024, b_w_o, 1024, 1, R, 1024, M, 1024, 1024, R, 1024);
    mlp(st, R, H, U, g_mlp + D, w_up + (size_t)D * FF, w_down + (size_t)FF * D);
    hipLaunchKernelGGL(rmsnorm_k, dim3(M / 4), dim3(256), 0, st, (const float*)R, g_final, R, M);
}
}

extern "C" void kernel_launch(void* const* d_in, const int* in_sizes, int n_in, void* d_out, int out_size, void* d_ws, size_t ws_size, hipStream_t stream) {
    if (ws_size < 512 * nv::MiB) { fprintf(stderr, "ws too small: %zu\n", ws_size); return; }
    nv::forward(d_in, (float*)d_out, (unsigned char*)d_ws, stream);
}
```

```cpp
#include <hip/hip_runtime.h>
#include <hip/hip_cooperative_groups.h>
#include <cstdio>
#include <cstdint>
#include <type_traits>
namespace cg = cooperative_groups;
__device__ __forceinline__ int lane_id_asm() { int l; asm volatile("v_mbcnt_lo_u32_b32 %0, -1, 0\n\tv_mbcnt_hi_u32_b32 %0, -1, %0" : "=v"(l)); return l; }
namespace pg8 {
#define PG8_LAS __attribute__((address_space(3)))
typedef unsigned short bf16_t;
typedef short bf16x8 __attribute__((ext_vector_type(8)));
typedef float f32x4 __attribute__((ext_vector_type(4)));
typedef unsigned u32x4 __attribute__((ext_vector_type(4)));
constexpr int BM = 256, BK = 64, HALF = 128, HTB = HALF * BK * 2  , STAGE_BYTES = 8 * HTB, NXCD = 8, WGM = 4;

__host__ __device__ __forceinline__ int lds_byte(int r, int c) { const int st = (r >> 4) * 2 + (c >> 5), rr = r & 15, cc = c & 31, ob = rr * 64 + cc * 2; return st * 1024 + (ob ^ (((ob >> 9) & 1) << 5)); }
__host__ __device__ __forceinline__ void stage_rc(int b, int& R, int& C) { const int st = b / 1024, sb = b % 1024, swz = sb ^ (((sb >> 9) & 1) << 5); R = (st >> 1) * 16 + swz / 64; C = (st & 1) * 32 + (swz % 64) / 2; }
__host__ __device__ __forceinline__ int perm32(int rho) { const int n = rho >> 4, i = rho & 15; return 8 * (i >> 2) + 4 * n + (i & 3); }

struct Unit { int pm, pn, ui; };
struct Gemm { const bf16_t* A; const bf16_t* Bt; int M, N, K; };

struct StaticOrder {
    int nM, nN, nwg, G, c;
    __host__ __device__ void init(int M, int N, int G_, int c_) { nM = M / BM; nN = N / BM; nwg = nM * nN; G = G_; c = c_; }
    __host__ __device__ bool next(int i, Unit& u) const {
        const long L = (long)i * G + c; if (L >= nwg) return false;
        int wgid = (int)L; { const int q = nwg / NXCD, r = nwg % NXCD, xcd = wgid % NXCD, off = wgid / NXCD; wgid = (xcd < r ? xcd * (q + 1) : r * (q + 1) + (xcd - r) * q) + off; }
        const int nig = WGM * nN, gid = wgid / nig, fm = gid * WGM, gsz = (nM - fm) < WGM ? (nM - fm) : WGM;
        u.pm = fm + ((wgid % nig) % gsz); u.pn = (wgid % nig) / gsz; return true;
    }
    __device__ __forceinline__ void a_ready(const Unit&) const {}
    __device__ __forceinline__ void done(const Unit&) const {}
};

template <int NM, int NCH> struct ChunkOrder {
    int G, c;
    __host__ __device__ bool next(int i, Unit& u) const {
        constexpr int nwgc = NM * 4;
        if (c >= nwgc) return false;
        const int nv = (nwgc - c + G - 1) / G;
        int ch = 0, ii = i; while (ii >= nv) { ii -= nv; ++ch; }
        if (ch >= NCH) return false;
        int wgid = ii * G + c; { constexpr int q = nwgc / NXCD, r = nwgc % NXCD; const int xcd = wgid % NXCD, off = wgid / NXCD; wgid = (xcd < r ? xcd * (q + 1) : r * (q + 1) + (xcd - r) * q) + off; }
        constexpr int nig = WGM * 4; const int gid = wgid / nig, fm = gid * WGM, gsz = (NM - fm) < WGM ? (NM - fm) : WGM;
        u.pm = fm + ((wgid % nig) % gsz); u.pn = 4 * ch + (wgid % nig) / gsz; return true;
    }
    __device__ __forceinline__ void a_ready(const Unit&) const {}
    __device__ __forceinline__ void done(const Unit&) const {}
};

__device__ __forceinline__ unsigned cvt_pk_bf16(float lo, float hi) { unsigned r; asm volatile("v_cvt_pk_bf16_f32 %0, %1, %2" : "=v"(r) : "v"(lo), "v"(hi)); return r; }
typedef _Float16 h16x2 __attribute__((ext_vector_type(2)));
__device__ __forceinline__ unsigned cvt_pk_f16(float lo, float hi) { h16x2 v = {(_Float16)lo, (_Float16)hi}; return __builtin_bit_cast(unsigned, v); }

struct EpiF32 {
    static constexpr bool PERM = false, AFTER_DRAIN = false;
    float* O; int ldc;
    __device__ __forceinline__ void operator()(const f32x4 (&acc)[2][2][4][2], const Unit& u, int wr, int wc, int fr, int fq) const {
        const int col0 = u.pn * BM + wc * 32 + 4 * fq;
#pragma unroll
        for (int ai = 0; ai < 2; ++ai)
#pragma unroll
            for (int m = 0; m < 4; ++m) { const size_t off = (size_t)(u.pm * BM + ai * HALF + wr * 64 + m * 16 + fr) * ldc + col0;
#pragma unroll
                for (int bj = 0; bj < 2; ++bj)
#pragma unroll
                    for (int n = 0; n < 2; ++n) *(f32x4*)(O + off + bj * HALF + n * 16) = acc[ai][bj][m][n]; }
    }
};
struct EpiPart {
    static constexpr bool PERM = false, AFTER_DRAIN = false;
    float* O;
    __device__ __forceinline__ void operator()(const f32x4 (&acc)[2][2][4][2], const Unit& u, int wr, int wc, int fr, int fq) const {
        const int col0 = wc * 32 + 4 * fq;
#pragma unroll
        for (int ai = 0; ai < 2; ++ai)
#pragma unroll
            for (int m = 0; m < 4; ++m) { const size_t off = (size_t)(u.pm * BM + ai * HALF + wr * 64 + m * 16 + fr) * 256 + col0;
#pragma unroll
                for (int bj = 0; bj < 2; ++bj)
#pragma unroll
                    for (int n = 0; n < 2; ++n) *(f32x4*)(O + off + bj * HALF + n * 16) = acc[ai][bj][m][n]; }
    }
};
template <bool BASE_F32> struct EpiResB {
    static constexpr bool PERM = true, AFTER_DRAIN = false;
    const float* basef; bf16_t* Rb; float* SSQ; int ldc;
    __device__ __forceinline__ void operator()(const f32x4 (&acc)[2][2][4][2], const Unit& u, int wr, int wc, int fr, int fq) const {
        const int col0 = u.pn * BM + wc * 32 + 8 * fq; const int row0 = u.pm * BM + wr * 64 + fr;
        float ssv[2][4];
        if constexpr (BASE_F32) {
#pragma unroll
            for (int ai = 0; ai < 2; ++ai) { f32x4 bs[4][2][2];
#pragma unroll
                for (int m = 0; m < 4; ++m)
#pragma unroll
                    for (int bj = 0; bj < 2; ++bj) { const float* bp = basef + (size_t)(row0 + ai * HALF + m * 16) * ldc + col0 + bj * HALF; bs[m][bj][0] = *(const f32x4*)bp; bs[m][bj][1] = *(const f32x4*)(bp + 4); }
#pragma unroll
                for (int m = 0; m < 4; ++m) { float ss = 0.f;
#pragma unroll
                    for (int bj = 0; bj < 2; ++bj) { const f32x4 v0 = bs[m][bj][0] + acc[ai][bj][m][0], v1 = bs[m][bj][1] + acc[ai][bj][m][1];
                        ss += ((v0[0] * v0[0] + v0[1] * v0[1]) + (v0[2] * v0[2] + v0[3] * v0[3])) + ((v1[0] * v1[0] + v1[1] * v1[1]) + (v1[2] * v1[2] + v1[3] * v1[3]));
                        u32x4 o; o.x = cvt_pk_bf16(v0[0], v0[1]); o.y = cvt_pk_bf16(v0[2], v0[3]); o.z = cvt_pk_bf16(v1[0], v1[1]); o.w = cvt_pk_bf16(v1[2], v1[3]);
                        *(u32x4*)(Rb + (size_t)(row0 + ai * HALF + m * 16) * ldc + col0 + bj * HALF) = o; }
                    ssv[ai][m] = ss; } }
        } else {
            u32x4 ws[2][4][2];
#pragma unroll
            for (int ai = 0; ai < 2; ++ai)
#pragma unroll
                for (int m = 0; m < 4; ++m)
#pragma unroll
                    for (int bj = 0; bj < 2; ++bj) ws[ai][m][bj] = *(const u32x4*)(Rb + (size_t)(row0 + ai * HALF + m * 16) * ldc + col0 + bj * HALF);
#pragma unroll
            for (int ai = 0; ai < 2; ++ai)
#pragma unroll
                for (int m = 0; m < 4; ++m) { float ss = 0.f;
#pragma unroll
                    for (int bj = 0; bj < 2; ++bj) { const u32x4 w = ws[ai][m][bj]; f32x4 b0, b1;
                        b0[0] = __builtin_bit_cast(float, w.x << 16); b0[1] = __builtin_bit_cast(float, w.x & 0xffff0000u); b0[2] = __builtin_bit_cast(float, w.y << 16); b0[3] = __builtin_bit_cast(float, w.y & 0xffff0000u);
                        b1[0] = __builtin_bit_cast(float, w.z << 16); b1[1] = __builtin_bit_cast(float, w.z & 0xffff0000u); b1[2] = __builtin_bit_cast(float, w.w << 16); b1[3] = __builtin_bit_cast(float, w.w & 0xffff0000u);
                        const f32x4 v0 = b0 + acc[ai][bj][m][0], v1 = b1 + acc[ai][bj][m][1];
                        ss += ((v0[0] * v0[0] + v0[1] * v0[1]) + (v0[2] * v0[2] + v0[3] * v0[3])) + ((v1[0] * v1[0] + v1[1] * v1[1]) + (v1[2] * v1[2] + v1[3] * v1[3]));
                        u32x4 o; o.x = cvt_pk_bf16(v0[0], v0[1]); o.y = cvt_pk_bf16(v0[2], v0[3]); o.z = cvt_pk_bf16(v1[0], v1[1]); o.w = cvt_pk_bf16(v1[2], v1[3]);
                        *(u32x4*)(Rb + (size_t)(row0 + ai * HALF + m * 16) * ldc + col0 + bj * HALF) = o; }
                    ssv[ai][m] = ss; }
        }
#pragma unroll
        for (int ai = 0; ai < 2; ++ai)
#pragma unroll
            for (int m = 0; m < 4; ++m) { float ss = ssv[ai][m]; ss += __shfl_xor(ss, 16); ss += __shfl_xor(ss, 32); ssv[ai][m] = ss; }
        if (fq == 0) {
#pragma unroll
            for (int ai = 0; ai < 2; ++ai)
#pragma unroll
                for (int m = 0; m < 4; ++m) SSQ[(size_t)(row0 + ai * HALF + m * 16) * 16 + u.pn * 4 + wc] = ssv[ai][m];
        }
    }
};
constexpr int RSTD_OFF = STAGE_BYTES;
constexpr int RSTD_MAXU = 8;
template <class Sched>
__device__ __forceinline__ void stage_rstd(PG8_LAS unsigned char* lds, const float* SSQ, const Sched& S, int tid) {
    PG8_LAS float* dst = (PG8_LAS float*)(lds + RSTD_OFF);
    const int r = tid & 255, i0 = tid >> 8;
    f32x4 t[RSTD_MAXU / 2]; bool has[RSTD_MAXU / 2];
#pragma unroll
    for (int j = 0; j < RSTD_MAXU / 2; ++j) { Unit u; has[j] = S.next(i0 + 2 * j, u); if (!has[j]) u.pm = 0;
        const f32x4* sp = (const f32x4*)(SSQ + (size_t)(u.pm * BM + r) * 16); t[j] = (sp[0] + sp[1]) + (sp[2] + sp[3]); }
#pragma unroll
    for (int j = 0; j < RSTD_MAXU / 2; ++j) if (has[j]) dst[(i0 + 2 * j) * 256 + r] = 1.0f / __builtin_sqrtf(((t[j][0] + t[j][1]) + (t[j][2] + t[j][3])) * (1.0f / 1024.0f) + 1e-6f);
    __syncthreads();
}
__device__ __forceinline__ void row_rstd(PG8_LAS unsigned char* lds, const Unit& u, int wr, int fr, float (&rs)[2][4]) {
    const PG8_LAS float* src = (const PG8_LAS float*)(lds + RSTD_OFF) + u.ui * 256 + wr * 64 + fr;
#pragma unroll
    for (int ai = 0; ai < 2; ++ai)
#pragma unroll
        for (int m = 0; m < 4; ++m) rs[ai][m] = src[ai * HALF + m * 16];
}
struct EpiRelu2 {
    static constexpr bool PERM = true, AFTER_DRAIN = false;
    bf16_t* O; int ldc; PG8_LAS unsigned char* L;
    __device__ __forceinline__ void operator()(const f32x4 (&acc)[2][2][4][2], const Unit& u, int wr, int wc, int fr, int fq) const {
        const int col0 = u.pn * BM + wc * 32 + 8 * fq;
        float rs[2][4]; row_rstd(L, u, wr, fr, rs);
#pragma unroll
        for (int ai = 0; ai < 2; ++ai)
#pragma unroll
            for (int m = 0; m < 4; ++m) { bf16_t* rowp = O + (size_t)(u.pm * BM + ai * HALF + wr * 64 + m * 16 + fr) * ldc + col0; const float r_ = rs[ai][m];
#pragma unroll
                for (int bj = 0; bj < 2; ++bj) { f32x4 v0 = acc[ai][bj][m][0], v1 = acc[ai][bj][m][1];
#pragma unroll
                    for (int e = 0; e < 4; ++e) { float a = v0[e] > 0.f ? v0[e] * r_ : 0.f, b = v1[e] > 0.f ? v1[e] * r_ : 0.f; v0[e] = a * a; v1[e] = b * b; }
                    u32x4 w; w.x = cvt_pk_bf16(v0[0], v0[1]); w.y = cvt_pk_bf16(v0[2], v0[3]); w.z = cvt_pk_bf16(v1[0], v1[1]); w.w = cvt_pk_bf16(v1[2], v1[3]);
                    *(u32x4*)(rowp + bj * HALF) = w; } }
    }
};
template <bool F16OUT> struct EpiPk {
    static constexpr bool PERM = true, AFTER_DRAIN = false;
    bf16_t* O; int ldc;
    __device__ __forceinline__ void operator()(const f32x4 (&acc)[2][2][4][2], const Unit& u, int wr, int wc, int fr, int fq) const {
        const int col0 = u.pn * BM + wc * 32 + 8 * fq;
#pragma unroll
        for (int ai = 0; ai < 2; ++ai)
#pragma unroll
            for (int m = 0; m < 4; ++m) { bf16_t* rowp = O + (size_t)(u.pm * BM + ai * HALF + wr * 64 + m * 16 + fr) * ldc + col0;
#pragma unroll
                for (int bj = 0; bj < 2; ++bj) { const f32x4 v0 = acc[ai][bj][m][0], v1 = acc[ai][bj][m][1]; u32x4 w;
                    if (!F16OUT) { w.x = cvt_pk_bf16(v0[0], v0[1]); w.y = cvt_pk_bf16(v0[2], v0[3]); w.z = cvt_pk_bf16(v1[0], v1[1]); w.w = cvt_pk_bf16(v1[2], v1[3]); }
                    else { w.x = cvt_pk_f16(v0[0], v0[1]); w.y = cvt_pk_f16(v0[2], v0[3]); w.z = cvt_pk_f16(v1[0], v1[1]); w.w = cvt_pk_f16(v1[2], v1[3]); }
                    *(u32x4*)(rowp + bj * HALF) = w; } }
    }
};
struct EpiPrep {
    static constexpr bool PERM = true, AFTER_DRAIN = true;
    bf16_t* CQ; bf16_t* CKV; bf16_t* KIDX; float* WIDX; const float* gkv; const float* gk; float wscale;
    __device__ __forceinline__ void operator()(const f32x4 (&)[2][2][4][2], const Unit&, int, int, int, int) const {}
    __device__ __forceinline__ void fused(const f32x4 (&acc)[2][2][4][2], const Unit& u, int wr, int wc, int fr, int fq, PG8_LAS unsigned char* lds, int wid, int lane) const {
        PG8_LAS float* red = (PG8_LAS float*)lds;
#pragma unroll
        for (int ai = 0; ai < 2; ++ai)
#pragma unroll
            for (int m = 0; m < 4; ++m) { float p[2];
#pragma unroll
                for (int bj = 0; bj < 2; ++bj) { const f32x4 v0 = acc[ai][bj][m][0], v1 = acc[ai][bj][m][1];
                    float t = ((v0[0] * v0[0] + v0[1] * v0[1]) + (v0[2] * v0[2] + v0[3] * v0[3])) + ((v1[0] * v1[0] + v1[1] * v1[1]) + (v1[2] * v1[2] + v1[3] * v1[3]));
                    t += __shfl_xor(t, 16); t += __shfl_xor(t, 32); p[bj] = t; }
                if (fq == 0) { PG8_LAS float* d = red + ((ai * HALF + wr * 64 + m * 16 + fr) * 4 + wc) * 2; d[0] = p[0]; d[1] = p[1]; } }
        __syncthreads();
#pragma unroll
        for (int ai = 0; ai < 2; ++ai)
#pragma unroll
            for (int m = 0; m < 4; ++m) { const int rt = ai * HALF + wr * 64 + m * 16 + fr; const size_t row = (size_t)u.pm * BM + rt;
                const f32x4 ra = *(const PG8_LAS f32x4*)(red + rt * 8), rb = *(const PG8_LAS f32x4*)(red + rt * 8 + 4);
                const float t0 = (ra[0] + ra[2]) + (rb[0] + rb[2]), t1 = (ra[1] + ra[3]) + (rb[1] + rb[3]), t1k = ra[1] + ra[3];
                if (u.pn == 0) { const float r_ = 1.0f / __builtin_sqrtf((t0 + t1) * (1.0f / 256.0f) + 1e-6f);
#pragma unroll
                    for (int bj = 0; bj < 2; ++bj) { const f32x4 v0 = acc[ai][bj][m][0] * r_, v1 = acc[ai][bj][m][1] * r_; u32x4 w;
                        w.x = cvt_pk_f16(v0[0], v0[1]); w.y = cvt_pk_f16(v0[2], v0[3]); w.z = cvt_pk_f16(v1[0], v1[1]); w.w = cvt_pk_f16(v1[2], v1[3]);
                        *(u32x4*)(CQ + row * 256 + bj * HALF + wc * 32 + 8 * fq) = w; }
                } else {
                    { const float r_ = 1.0f / __builtin_sqrtf(t0 * (1.0f / 128.0f) + 1e-6f); const int c = wc * 32 + 8 * fq;
                      const f32x4 g0 = *(const f32x4*)(gkv + c), g1 = *(const f32x4*)(gkv + c + 4); const f32x4 v0 = acc[ai][0][m][0] * r_ * g0, v1 = acc[ai][0][m][1] * r_ * g1; u32x4 w;
                      w.x = cvt_pk_bf16(v0[0], v0[1]); w.y = cvt_pk_bf16(v0[2], v0[3]); w.z = cvt_pk_bf16(v1[0], v1[1]); w.w = cvt_pk_bf16(v1[2], v1[3]);
                      *(u32x4*)(CKV + row * 128 + c) = w; }
                    if (wc < 2) { const float r_ = 1.0f / __builtin_sqrtf(t1k * (1.0f / 64.0f) + 1e-6f); const int c = wc * 32 + 8 * fq;
                      const f32x4 g0 = *(const f32x4*)(gk + c), g1 = *(const f32x4*)(gk + c + 4); const f32x4 v0 = acc[ai][1][m][0] * r_ * g0, v1 = acc[ai][1][m][1] * r_ * g1; u32x4 w;
                      w.x = cvt_pk_f16(v0[0], v0[1]); w.y = cvt_pk_f16(v0[2], v0[3]); w.z = cvt_pk_f16(v1[0], v1[1]); w.w = cvt_pk_f16(v1[2], v1[3]);
                      *(u32x4*)(KIDX + row * 64 + c) = w; }
                    else if (wc == 2 && fq == 0) { *(f32x4*)(WIDX + row * 8) = acc[ai][1][m][0] * wscale; *(f32x4*)(WIDX + row * 8 + 4) = acc[ai][1][m][1] * wscale; }
                } }
    }
};
struct EpiKVQ {
    static constexpr bool PERM = true, AFTER_DRAIN = false;
    bf16_t* KV; bf16_t* QN; PG8_LAS unsigned char* L; bf16_t* FLAT; const float* posk; const float* posv;
    __device__ __forceinline__ void operator()(const f32x4 (&acc)[2][2][4][2], const Unit& u, int wr, int wc, int fr, int fq) const {
        float rs[2][4]; row_rstd(L, u, wr, fr, rs);
        if (u.pn < 2) {
            const int part = u.pn; const float* pos = part ? posv : posk; const int d = wc * 32 + 8 * fq;
#pragma unroll
            for (int ai = 0; ai < 2; ++ai)
#pragma unroll
                for (int m = 0; m < 4; ++m) { const int mrow = u.pm * BM + ai * HALF + wr * 64 + m * 16 + fr, b = mrow >> 13, t = mrow & 8191, nA = t >> 4, jA = t & 15; const float r_ = rs[ai][m];
#pragma unroll
                    for (int bj = 0; bj < 2; ++bj) { const f32x4 v0 = acc[ai][bj][m][0] * r_, v1 = acc[ai][bj][m][1] * r_;
                        const unsigned w0 = cvt_pk_bf16(v0[0], v0[1]), w1 = cvt_pk_bf16(v0[2], v0[3]), w2 = cvt_pk_bf16(v1[0], v1[1]), w3 = cvt_pk_bf16(v1[2], v1[3]);
#pragma unroll
                        for (int win = 0; win < 2; ++win) { const int n = nA - win, j = jA + 16 * win;
                            if (n >= 0 && n <= 510) { const f32x4 p0 = *(const f32x4*)(pos + j * 128 + d), p1 = *(const f32x4*)(pos + j * 128 + d + 4); u32x4 o;
                                o.x = cvt_pk_bf16(__builtin_bit_cast(float, w0 << 16) + p0[0], __builtin_bit_cast(float, w0 & 0xffff0000u) + p0[1]);
                                o.y = cvt_pk_bf16(__builtin_bit_cast(float, w1 << 16) + p0[2], __builtin_bit_cast(float, w1 & 0xffff0000u) + p0[3]);
                                o.z = cvt_pk_bf16(__builtin_bit_cast(float, w2 << 16) + p1[0], __builtin_bit_cast(float, w2 & 0xffff0000u) + p1[1]);
                                o.w = cvt_pk_bf16(__builtin_bit_cast(float, w3 << 16) + p1[2], __builtin_bit_cast(float, w3 & 0xffff0000u) + p1[3]);
                                *(u32x4*)(FLAT + ((size_t)((part * 4 + (j >> 3)) * 4096 + (b * 511 + n) * 2 + bj) * 1024 + (j & 7) * 128 + d)) = o; } } } }
            return;
        }
        const bool iskv = u.pn < 6; const int ldc = iskv ? 1536 : 1024; bf16_t* base = iskv ? KV : QN;
        const int col0 = (iskv ? u.pn : u.pn - 6) * BM + wc * 32 + 8 * fq;
#pragma unroll
        for (int ai = 0; ai < 2; ++ai)
#pragma unroll
            for (int m = 0; m < 4; ++m) { bf16_t* rowp = base + (size_t)(u.pm * BM + ai * HALF + wr * 64 + m * 16 + fr) * ldc + col0; const float r_ = rs[ai][m];
#pragma unroll
                for (int bj = 0; bj < 2; ++bj) { const f32x4 v0 = acc[ai][bj][m][0] * r_, v1 = acc[ai][bj][m][1] * r_; u32x4 w;
                    w.x = cvt_pk_bf16(v0[0], v0[1]); w.y = cvt_pk_bf16(v0[2], v0[3]); w.z = cvt_pk_bf16(v1[0], v1[1]); w.w = cvt_pk_bf16(v1[2], v1[3]);
                    *(u32x4*)(rowp + bj * HALF) = w; } }
    }
};
struct EpiGate {
    static constexpr bool PERM = true, AFTER_DRAIN = false;
    float* GATES; PG8_LAS unsigned char* L;
    __device__ __forceinline__ void operator()(const f32x4 (&acc)[2][2][4][2], const Unit& u, int wr, int wc, int fr, int fq) const {
        float rs[2][4]; row_rstd(L, u, wr, fr, rs);
        if (wc == 0 && fq < 3) {
#pragma unroll
            for (int ai = 0; ai < 2; ++ai)
#pragma unroll
                for (int m = 0; m < 4; ++m) { float* rowp = GATES + (size_t)(u.pm * BM + ai * HALF + wr * 64 + m * 16 + fr) * 24 + 8 * fq; const float r_ = rs[ai][m];
#pragma unroll
                    for (int n = 0; n < 2; ++n) { f32x4 v = acc[ai][0][m][n];
#pragma unroll
                        for (int e = 0; e < 4; ++e) v[e] = 1.0f / (1.0f + __expf(-v[e] * r_));
                        *(f32x4*)(rowp + 4 * n) = v; } }
        }
    }
};
typedef _Float16 f16x8 __attribute__((ext_vector_type(8)));
__device__ __forceinline__ f32x4 mma16(bf16x8 a, bf16x8 b, f32x4 c, std::false_type) { return __builtin_amdgcn_mfma_f32_16x16x32_bf16(a, b, c, 0, 0, 0); }
__device__ __forceinline__ f32x4 mma16(bf16x8 a, bf16x8 b, f32x4 c, std::true_type) { return __builtin_amdgcn_mfma_f32_16x16x32_f16(__builtin_bit_cast(f16x8, a), __builtin_bit_cast(f16x8, b), c, 0, 0, 0); }
template <class Epi, class Sched, bool ALIGN_EPI = false, bool SP2 = false, bool F16 = false>
__device__ __forceinline__ void gemm_phase(PG8_LAS unsigned char* lds, const Gemm g, const Sched& S, const Epi& E, const int wave_sgpr) {
    const int lane = lane_id_asm(), wid = wave_sgpr, tid = wid * 64 + lane,
              wr = wid >> 2, wc = wid & 3, fr = lane & 15, fq = lane >> 4;
    const int K = g.K, nt = K / BK;
    unsigned voffA[2], voffB[2];
#pragma unroll
    for (int i = 0; i < 2; ++i) { int R, C; stage_rc(tid * 16 + i * 8192, R, C); const int Rb = Epi::PERM ? ((R & ~31) + perm32(R & 31)) : R;
        voffA[i] = (unsigned)(R * K + C) * 2u; voffB[i] = (unsigned)(Rb * K + C) * 2u; }
    const size_t kstep = (size_t)(BK * 2);
    const size_t hstep = (size_t)HALF * K * 2;
    const size_t tstep = 2 * hstep;
    const unsigned ldsw = (unsigned)wid * 1024u;
    const int aoff = lds_byte(wr * 64 + fr, fq * 8), boff = lds_byte(wc * 32 + fr, fq * 8);
#define PG8_SA(b, h) (((b) * 2 + (h)) * HTB)
#define PG8_SB(b, h) ((4 + (b) * 2 + (h)) * HTB)
#define PG8_STAGE(bufoff, gbase, voff) do { _Pragma("unroll") for (int _i = 0; _i < 2; ++_i) \
        __builtin_amdgcn_global_load_lds((const unsigned*)((const char*)(gbase) + (voff)[_i]), (PG8_LAS unsigned*)(lds + (bufoff) + ldsw + _i * 8192), 16, 0, 0); } while (0)
#define PG8_LDA(dst, b, h) do { _Pragma("unroll") for (int m = 0; m < 4; ++m) _Pragma("unroll") for (int k = 0; k < 2; ++k) dst[m][k] = *(const PG8_LAS bf16x8*)(lds + PG8_SA(b, h) + aoff + m * 2048 + k * 1024); } while (0)
#define PG8_LDB(dst, b, h) do { _Pragma("unroll") for (int n = 0; n < 2; ++n) _Pragma("unroll") for (int k = 0; k < 2; ++k) dst[n][k] = *(const PG8_LAS bf16x8*)(lds + PG8_SB(b, h) + boff + n * 2048 + k * 1024); } while (0)
#define PG8_MMA(ai, bj, At, Bt) do { __builtin_amdgcn_s_setprio(1); _Pragma("unroll") for (int m = 0; m < 4; ++m) _Pragma("unroll") for (int n = 0; n < 2; ++n) _Pragma("unroll") for (int k = 0; k < 2; ++k) \
        acc[ai][bj][m][n] = mma16(Bt[n][k], At[m][k], acc[ai][bj][m][n], std::integral_constant<bool, F16>()); __builtin_amdgcn_s_setprio(0); } while (0)
#define PG8_WAIT_V(n) asm volatile("s_waitcnt vmcnt(" #n ")" ::: "memory")
#define PG8_WAIT_L(n) asm volatile("s_waitcnt lgkmcnt(" #n ")" ::: "memory")
#define PG8_BAR __builtin_amdgcn_s_barrier()
#define PG8_SCHED __builtin_amdgcn_sched_barrier(0)
    Unit cur, nxt; int ui = 0;
    if (!S.next(0, cur)) return;
    cur.ui = 0;
    f32x4 acc[2][2][4][2];
#pragma unroll
    for (int a = 0; a < 2; ++a)
#pragma unroll
        for (int b = 0; b < 2; ++b)
#pragma unroll
            for (int m = 0; m < 4; ++m)
#pragma unroll
                for (int n = 0; n < 2; ++n) acc[a][b][m][n] = (f32x4){0.f, 0.f, 0.f, 0.f};
    bf16x8 At[4][2], B0[2][2], B1[2][2];
    const char* cA = (const char*)g.A + (size_t)cur.pm * tstep; const char* cB = (const char*)g.Bt + (size_t)cur.pn * tstep;
    S.a_ready(cur);
    if constexpr (SP2) {
        PG8_STAGE(PG8_SB(0, 0), cB, voffB); PG8_STAGE(PG8_SB(0, 1), cB + hstep, voffB); PG8_STAGE(PG8_SA(0, 0), cA, voffA); PG8_STAGE(PG8_SA(0, 1), cA + hstep, voffA);
        if (wr == 1) PG8_BAR;
        PG8_WAIT_V(2); PG8_BAR;
        PG8_STAGE(PG8_SB(1, 0), cB + kstep, voffB); PG8_STAGE(PG8_SA(1, 0), cA + kstep, voffA); PG8_STAGE(PG8_SB(1, 1), cB + hstep + kstep, voffB);
        PG8_WAIT_V(6); PG8_BAR;
    } else {
        PG8_STAGE(PG8_SB(0, 0), cB, voffB); PG8_STAGE(PG8_SA(0, 0), cA, voffA); PG8_STAGE(PG8_SB(0, 1), cB + hstep, voffB); PG8_STAGE(PG8_SA(0, 1), cA + hstep, voffA);
        if (wr == 1) PG8_BAR;
        PG8_WAIT_V(4); PG8_BAR;
        PG8_STAGE(PG8_SB(1, 0), cB + kstep, voffB); PG8_STAGE(PG8_SA(1, 0), cA + kstep, voffA); PG8_STAGE(PG8_SB(1, 1), cB + hstep + kstep, voffB);
        PG8_WAIT_V(6); PG8_BAR;
    }
    for (;;) {
        const bool has_next = S.next(ui + 1, nxt); nxt.ui = ui + 1;
        const char* nA = has_next ? (const char*)g.A + (size_t)nxt.pm * tstep : cA; const char* nB = has_next ? (const char*)g.Bt + (size_t)nxt.pn * tstep : cB;
#pragma unroll 1
        for (int t = 0; t < nt; t += 2) {
            const bool last = (t == nt - 2);
            const char* a1 = cA + (size_t)(t + 1) * kstep;
            const char* a2 = last ? nA : cA + (size_t)(t + 2) * kstep; const char* b2 = last ? nB : cB + (size_t)(t + 2) * kstep;
            const char* a3 = a2 + kstep; const char* b3 = b2 + kstep;
            if (last && has_next) S.a_ready(nxt);
            if constexpr (SP2) {
            PG8_LDB(B0, 0, 0); PG8_LDB(B1, 0, 1); PG8_SCHED; PG8_LDA(At, 0, 0); PG8_STAGE(PG8_SA(1, 1), a1 + hstep, voffA);
            PG8_WAIT_V(8); PG8_WAIT_L(0); PG8_BAR; PG8_MMA(0, 0, At, B0); PG8_MMA(0, 1, At, B1); PG8_BAR; PG8_SCHED;
            PG8_LDA(At, 0, 1); PG8_STAGE(PG8_SB(0, 0), b2, voffB); PG8_STAGE(PG8_SB(0, 1), b2 + hstep, voffB); PG8_STAGE(PG8_SA(0, 0), a2, voffA);
            PG8_WAIT_V(8); PG8_WAIT_L(0); PG8_BAR; PG8_MMA(1, 0, At, B0); PG8_MMA(1, 1, At, B1); PG8_BAR; PG8_SCHED;
            PG8_LDB(B0, 1, 0); PG8_LDB(B1, 1, 1); PG8_SCHED; PG8_LDA(At, 1, 0); PG8_STAGE(PG8_SA(0, 1), a2 + hstep, voffA);
            PG8_WAIT_V(8); PG8_WAIT_L(0); PG8_BAR; PG8_MMA(0, 0, At, B0); PG8_MMA(0, 1, At, B1); PG8_BAR; PG8_SCHED;
            PG8_LDA(At, 1, 1); PG8_STAGE(PG8_SB(1, 0), b3, voffB); PG8_STAGE(PG8_SB(1, 1), b3 + hstep, voffB); PG8_STAGE(PG8_SA(1, 0), a3, voffA);
            PG8_WAIT_V(8); PG8_WAIT_L(0); PG8_BAR; PG8_MMA(1, 0, At, B0); PG8_MMA(1, 1, At, B1); PG8_BAR; PG8_SCHED;
            } else {
            PG8_LDB(B0, 0, 0); PG8_SCHED; PG8_LDA(At, 0, 0); PG8_STAGE(PG8_SA(1, 1), a1 + hstep, voffA);
            PG8_WAIT_L(8); PG8_BAR; PG8_WAIT_L(0); PG8_MMA(0, 0, At, B0); PG8_BAR; PG8_SCHED;
            PG8_LDB(B1, 0, 1); PG8_STAGE(PG8_SB(0, 0), b2, voffB);
            PG8_BAR; PG8_WAIT_L(0); PG8_MMA(0, 1, At, B1); PG8_BAR;
            PG8_LDA(At, 0, 1); PG8_STAGE(PG8_SA(0, 0), a2, voffA);
            PG8_BAR; PG8_WAIT_L(0); PG8_MMA(1, 0, At, B0); PG8_BAR; PG8_SCHED;
            PG8_STAGE(PG8_SB(0, 1), b2 + hstep, voffB);
            PG8_WAIT_V(6); PG8_BAR; PG8_MMA(1, 1, At, B1); PG8_BAR;
            PG8_LDB(B0, 1, 0); PG8_SCHED; PG8_LDA(At, 1, 0); PG8_STAGE(PG8_SA(0, 1), a2 + hstep, voffA);
            PG8_WAIT_L(8); PG8_BAR; PG8_WAIT_L(0); PG8_MMA(0, 0, At, B0); PG8_BAR; PG8_SCHED;
            PG8_LDB(B1, 1, 1); PG8_STAGE(PG8_SB(1, 0), b3, voffB);
            PG8_BAR; PG8_WAIT_L(0); PG8_MMA(0, 1, At, B1); PG8_BAR;
            PG8_LDA(At, 1, 1); PG8_STAGE(PG8_SA(1, 0), a3, voffA);
            PG8_BAR; PG8_WAIT_L(0); PG8_MMA(1, 0, At, B0); PG8_BAR; PG8_SCHED;
            PG8_STAGE(PG8_SB(1, 1), b3 + hstep, voffB);
            PG8_WAIT_V(6); PG8_BAR; PG8_MMA(1, 1, At, B1); PG8_BAR;
            }
        }
        if constexpr (ALIGN_EPI) { if (wr == 0) PG8_BAR; }
        if constexpr (!Epi::AFTER_DRAIN) { E(acc, cur, wr, wc, fr, fq); S.done(cur); }
        if (!has_next) break;
#pragma unroll
        for (int a = 0; a < 2; ++a)
#pragma unroll
            for (int b = 0; b < 2; ++b)
#pragma unroll
                for (int m = 0; m < 4; ++m)
#pragma unroll
                    for (int n = 0; n < 2; ++n) acc[a][b][m][n] = (f32x4){0.f, 0.f, 0.f, 0.f};
        cur = nxt; cA = nA; cB = nB; ++ui;
        if constexpr (ALIGN_EPI) { if (wr == 1) PG8_BAR; }
    }
    PG8_WAIT_V(0);
    if constexpr (!ALIGN_EPI) { if (wr == 0) PG8_BAR; }
    PG8_BAR;
    if constexpr (Epi::AFTER_DRAIN) { E.fused(acc, cur, wr, wc, fr, fq, lds, wid, lane); S.done(cur); }
#undef PG8_SA
#undef PG8_SB
#undef PG8_STAGE
#undef PG8_LDA
#undef PG8_LDB
#undef PG8_MMA
#undef PG8_WAIT_V
#undef PG8_WAIT_L
#undef PG8_BAR
#undef PG8_SCHED
}
}

constexpr int NWAVES = 8, NTHR = 512;
constexpr int BATCH = 4, T = 8192, D = 1024, M = BATCH * T, FF = 4096;
constexpr int PW = 456, QPW = 1048, KVW = 1536, NCMP = 511;
constexpr float NEGF = -1e30f;
constexpr float QK_SCALE = 0.08838834764831845f;
constexpr float WIDX_SCALE = 0.04419417382415922f;
constexpr size_t MiB = 1u << 20;
constexpr size_t WS_BIASV = 1 * MiB;
constexpr size_t WS_W_IN0 = 2 * MiB;
constexpr size_t WS_W_Q2 = 3 * MiB;
constexpr size_t WS_W_UVO = 4 * MiB;
constexpr size_t WS_W_UP = 6 * MiB;
constexpr size_t WS_W_DN = 22 * MiB;
constexpr size_t WS_W_KVQ = 38 * MiB;
constexpr size_t WS_W_O1 = 44 * MiB;
constexpr size_t WS_W_C1 = 46 * MiB;
constexpr size_t WS_CBIAS = 50 * MiB;
constexpr size_t WS_SSQ = 52 * MiB;
constexpr size_t WS_RB = 448 * MiB;
constexpr size_t WS_XN = 64 * MiB;
constexpr size_t WS_S = 128 * MiB;
constexpr size_t WS_PROJ0 = WS_S;
constexpr size_t WS_CQ = WS_S + 64 * MiB;
constexpr size_t WS_CKV = WS_S + 80 * MiB;
constexpr size_t WS_KIDX = WS_S + 88 * MiB;
constexpr size_t WS_WIDX = WS_S + 92 * MiB;
constexpr size_t WS_QIDX = WS_S + 96 * MiB;
constexpr size_t WS_QABS = WS_S + 128 * MiB;
constexpr size_t WS_SEL = WS_S + 192 * MiB;
constexpr size_t WS_U = WS_S;
constexpr size_t WS_KV = WS_S;
constexpr size_t WS_QN = WS_S + 98 * MiB;
constexpr size_t WS_GATES = WS_S + 162 * MiB;
constexpr size_t WS_KC = WS_S + 166 * MiB;
constexpr size_t WS_VC = WS_S + 167 * MiB;
constexpr size_t WS_FLAT = 384 * MiB;
constexpr size_t WS_PART = 300 * MiB;
constexpr size_t WS_END = 512 * MiB;
constexpr int RING_BYTES = 131072, LDS_BYTES = 147456;

#define GAS __attribute__((address_space(1)))
#define LAS __attribute__((address_space(3)))
typedef unsigned short bf16;
typedef unsigned v4u __attribute__((ext_vector_type(4)));
typedef unsigned v2u __attribute__((ext_vector_type(2)));
typedef float f32x4 __attribute__((ext_vector_type(4)));
typedef float f32x2 __attribute__((ext_vector_type(2)));
#define LDS_WAIT() asm volatile("s_waitcnt lgkmcnt(0)" ::: "memory")
__device__ __forceinline__ unsigned f2bf(float f) { unsigned u = __builtin_bit_cast(unsigned, f); return (u + 0x7fffu + ((u >> 16) & 1u)) >> 16; }
__device__ __forceinline__ unsigned pk2(float lo, float hi) { return f2bf(lo) | (f2bf(hi) << 16); }
__device__ __forceinline__ unsigned short f2h_(float f) { return __builtin_bit_cast(unsigned short, (_Float16)f); }
__device__ __forceinline__ unsigned pkh2(float lo, float hi) { return (unsigned)f2h_(lo) | ((unsigned)f2h_(hi) << 16); }
__device__ __forceinline__ unsigned pk2x(float lo, float hi, bool f16) { return f16 ? pkh2(lo, hi) : pk2(lo, hi); }
__device__ __forceinline__ float bf2f(unsigned short b) { return __builtin_bit_cast(float, (unsigned)b << 16); }
__device__ __forceinline__ float bflo(unsigned w) { return __builtin_bit_cast(float, w << 16); }
__device__ __forceinline__ float bfhi(unsigned w) { return __builtin_bit_cast(float, w & 0xffff0000u); }
__device__ __forceinline__ float h2f(unsigned short h) { return (float)__builtin_bit_cast(_Float16, h); }
__device__ __forceinline__ unsigned short f2h(float f) { return __builtin_bit_cast(unsigned short, (_Float16)f); }
__device__ __forceinline__ float wave_sum(float v) {
#pragma unroll
    for (int o = 1; o < 64; o <<= 1) v += __shfl_xor(v, o);
    return v;
}
__device__ __forceinline__ float wave_max(float v) {
#pragma unroll
    for (int o = 1; o < 64; o <<= 1) v = fmaxf(v, __shfl_xor(v, o));
    return v;
}
__device__ __forceinline__ int rel_bucket(int dist) {
    if (dist < 16) return dist < 0 ? 0 : dist;
    const int v = 39 - __clz(dist * dist);
    return v > 31 ? 31 : v;
}

struct Params {
    const float* in[26]; float* out; unsigned char* ws; int ph_lo, ph_hi;
};
struct Frame { LAS unsigned char* lds; int tid, lane, wave, G, gw, NGW; };

struct TrDesc { const float* W; int ldw, Nreal, K; bf16* WT; int row_off; const float* gain; float sc; int sc_cols, item, nblk; bool f16; };
__device__ __forceinline__ void tr_load(const TrDesc& d, int lane, f32x4 (&v)[8], float (&gv)[8]) {
    const int kb = d.item / d.nblk, nb = d.item % d.nblk, k0 = 64 * kb, n = 32 * nb + 4 * (lane & 7), kr = lane >> 3;
#pragma unroll
    for (int i = 0; i < 8; ++i) { const int kk = 8 * i + kr; f32x4 z = {0.f, 0.f, 0.f, 0.f};
        v[i] = (n < d.Nreal) ? *(const f32x4*)(d.W + (size_t)(k0 + kk) * d.ldw + n) : z; gv[i] = d.gain ? d.gain[k0 + kk] : 1.0f; }
}
__device__ __forceinline__ void tr_finish(const TrDesc& d, LAS float* scr, int lane, const f32x4 (&v)[8], const float (&gv)[8]) {
    const int kb = d.item / d.nblk, nb = d.item % d.nblk, k0 = 64 * kb, n0 = 32 * nb, n4 = 4 * (lane & 7), kr = lane >> 3;
    const float scl = (n0 + n4 < d.sc_cols) ? d.sc : 1.0f;
#pragma unroll
    for (int i = 0; i < 8; ++i) { const int kk = 8 * i + kr; const float g = gv[i] * scl; LAS float* p = scr + kk * 33 + n4;
        p[0] = v[i].x * g; p[1] = v[i].y * g; p[2] = v[i].z * g; p[3] = v[i].w * g; }
    LDS_WAIT(); asm volatile("" ::: "memory");
    const int c = lane & 7;
#pragma unroll
    for (int j = 0; j < 4; ++j) { const int n = (lane >> 3) + 8 * j; const LAS float* sp = scr + (8 * c) * 33 + n;
        v4u o; o.x = pk2x(sp[0 * 33], sp[1 * 33], d.f16); o.y = pk2x(sp[2 * 33], sp[3 * 33], d.f16); o.z = pk2x(sp[4 * 33], sp[5 * 33], d.f16); o.w = pk2x(sp[6 * 33], sp[7 * 33], d.f16);
        *(v4u*)(d.WT + (size_t)(d.row_off + n0 + n) * d.K + k0 + 8 * c) = o; }
    LDS_WAIT(); asm volatile("" ::: "memory");
}
__device__ __forceinline__ void norm_row_bf16(const float* xrow, bf16* orow, int lane, bool f16 = false) {
    const f32x4* xr = (const f32x4*)xrow + lane;
    f32x4 v[4]; float s = 0.f;
#pragma unroll
    for (int j = 0; j < 4; ++j) { v[j] = xr[64 * j]; s += (v[j].x * v[j].x + v[j].y * v[j].y) + (v[j].z * v[j].z + v[j].w * v[j].w); }
    const float r = 1.0f / sqrtf(wave_sum(s) * (1.f / D) + 1e-6f);
    v2u* o8 = (v2u*)orow + lane;
#pragma unroll
    for (int j = 0; j < 4; ++j) { v2u w; w.x = pk2x(v[j].x * r, v[j].y * r, f16); w.y = pk2x(v[j].z * r, v[j].w * r, f16); o8[64 * j] = w; }
}
__device__ __forceinline__ void ph_norm(const Frame& F, const float* X, bf16* XN, bool f16 = false) {
    for (int m = F.gw; m < M; m += 4 * F.NGW) {
        f32x4 v[4][4]; float ss[4];
#pragma unroll
        for (int rr = 0; rr < 4; ++rr) { const f32x4* xa = (const f32x4*)(X + (size_t)(m + rr * F.NGW) * D) + F.lane;
#pragma unroll
            for (int j = 0; j < 4; ++j) v[rr][j] = xa[64 * j]; }
#pragma unroll
        for (int rr = 0; rr < 4; ++rr) { float sa = 0.f;
#pragma unroll
            for (int j = 0; j < 4; ++j) sa += (v[rr][j].x * v[rr][j].x + v[rr][j].y * v[rr][j].y) + (v[rr][j].z * v[rr][j].z + v[rr][j].w * v[rr][j].w);
            ss[rr] = sa; }
#pragma unroll
        for (int o = 1; o < 64; o <<= 1) {
#pragma unroll
            for (int rr = 0; rr < 4; ++rr) ss[rr] += __shfl_xor(ss[rr], o); }
#pragma unroll
        for (int rr = 0; rr < 4; ++rr) { const float ra = 1.0f / sqrtf(ss[rr] * (1.f / D) + 1e-6f); v2u* oa = (v2u*)(XN + (size_t)(m + rr * F.NGW) * D) + F.lane;
#pragma unroll
            for (int j = 0; j < 4; ++j) { v2u wa; wa.x = pk2x(v[rr][j].x * ra, v[rr][j].y * ra, f16); wa.y = pk2x(v[rr][j].z * ra, v[rr][j].w * ra, f16); oa[64 * j] = wa; } }
    }
}
__device__ __forceinline__ void ph_final_norm(const Frame& F, const bf16* Rb, const float* SSQ, float* out, const float* g) {
    for (int m = F.gw; m < M; m += F.NGW) {
        const f32x4* sp = (const f32x4*)(SSQ + (size_t)m * 16); const f32x4 t = (sp[0] + sp[1]) + (sp[2] + sp[3]);
        const float r = 1.0f / sqrtf(((t[0] + t[1]) + (t[2] + t[3])) * (1.f / D) + 1e-6f);
        const v2u* xr = (const v2u*)(Rb + (size_t)m * D) + F.lane; f32x4* orow = (f32x4*)(out + (size_t)m * D) + F.lane; const f32x4* gr = (const f32x4*)g + F.lane;
#pragma unroll
        for (int j = 0; j < 4; ++j) { const v2u w = xr[64 * j]; const f32x4 gg = gr[64 * j]; f32x4 o;
            o.x = bflo(w.x) * r * gg.x; o.y = bfhi(w.x) * r * gg.y; o.z = bflo(w.y) * r * gg.z; o.w = bfhi(w.y) * r * gg.w; orow[64 * j] = o; }
    }
}

__device__ __forceinline__ void ph_prologue(const Frame& F, const Params& P) {
    unsigned char* ws = P.ws;
    LAS float* scr = (LAS float*)(F.lds + F.wave * 16384);
    const float* g_attn = P.in[1]; const float* g_mlp = P.in[2];
    constexpr int I_IN0 = 16 * 16, I_UP = 16 * 128, I_DN = 64 * 32, I_KV = 16 * 48, I_IN1 = 16 * 40, I_O1 = 16 * 32, I_QI = 4 * 16, I_C1 = 16 * 8;
    constexpr int NITEMS = I_IN0 + 2 * I_UP + 2 * I_DN + I_KV + I_IN1 + I_O1 + I_QI + 8 * I_C1;
    auto decode = [&](int it, TrDesc& d) -> bool {
        if (it >= NITEMS) return false;
        int r = it;
        if (r < I_IN0) { d = TrDesc{P.in[6], PW, PW, D, (bf16*)(ws + WS_W_IN0), 0, g_attn, 1.f, 0, r, 16, true}; return true; } r -= I_IN0;
        if (r < 2 * I_UP) { const int l = r / I_UP; r -= l * I_UP; d = TrDesc{P.in[3] + (size_t)l * D * FF, FF, FF, D, (bf16*)(ws + WS_W_UP) + (size_t)l * FF * D, 0, g_mlp + l * D, 1.f, 0, r, 128, false}; return true; } r -= 2 * I_UP;
        if (r < 2 * I_DN) { const int l = r / I_DN; r -= l * I_DN; d = TrDesc{P.in[4] + (size_t)l * FF * D, D, D, FF, (bf16*)(ws + WS_W_DN) + (size_t)l * D * FF, 0, nullptr, 1.f, 0, r, 32, false}; return true; } r -= 2 * I_DN;
        if (r < I_KV) { d = TrDesc{P.in[16], KVW, KVW, D, (bf16*)(ws + WS_W_KVQ), 0, P.in[15], 1.f, 0, r, 48, false}; return true; } r -= I_KV;
        if (r < I_IN1) { d = TrDesc{P.in[23], QPW, QPW, D, (bf16*)(ws + WS_W_KVQ), KVW, g_attn + D, QK_SCALE * 1.4426950408889634f  , 1024, r, 40, false}; return true; } r -= I_IN1;
        if (r < I_O1) { d = TrDesc{P.in[24], D, D, D, (bf16*)(ws + WS_W_O1), 0, nullptr, 1.f, 0, r, 32, false}; return true; } r -= I_O1;
        if (r < I_QI) { d = TrDesc{P.in[11], 512, 512, 256, (bf16*)(ws + WS_W_Q2), 1024, P.in[7], 1.f, 0, r, 16, true}; return true; } r -= I_QI;
        { const int sl = r / I_C1; r -= sl * I_C1; const int part = sl >> 2, ks = sl & 3;
          d = TrDesc{P.in[part ? 21 : 19] + (size_t)ks * 1024 * 256, 256, 256, 1024, (bf16*)(ws + WS_W_C1) + (size_t)sl * 256 * 1024, 0, nullptr, 1.f, 0, r, 8, false}; return true; }
    };
    {
        TrDesc dc, dn; f32x4 vc[8], vn[8]; float gc[8], gn[8];
        int it = F.gw; bool hc = decode(it, dc);
        if (hc) tr_load(dc, F.lane, vc, gc);
#pragma unroll 1
        while (hc) {
            const bool hn = decode(it + F.NGW, dn);
            if (hn) tr_load(dn, F.lane, vn, gn);
            tr_finish(dc, scr, F.lane, vc, gc);
            dc = dn; hc = hn; it += F.NGW;
#pragma unroll
            for (int i = 0; i < 8; ++i) { vc[i] = vn[i]; gc[i] = gn[i]; }
        }
    }
    {
        const float* w_uq = P.in[10]; const float* w_uk = P.in[12]; const float* gq = P.in[7]; unsigned short* WQ = (unsigned short*)(ws + WS_W_Q2);
        const int fr = F.lane & 15, fq = F.lane >> 4;
        for (int tile = F.gw; tile < 1024; tile += F.NGW) {
            const int h = tile >> 7, rt = (tile >> 3) & 15, ct = tile & 7;
            const float* ap = w_uq + (size_t)(rt * 16 + fr) * 1024 + h * 128 + 4 * fq; const float* bp = w_uk + (size_t)(ct * 16 + fr) * 1024 + h * 128 + 4 * fq;
            f32x4 av[8], bv[8];
#pragma unroll
            for (int sx = 0; sx < 8; ++sx) { av[sx] = *(const f32x4*)(ap + 16 * sx); bv[sx] = *(const f32x4*)(bp + 16 * sx); }
            f32x4 acc = {0.f, 0.f, 0.f, 0.f};
#pragma unroll
            for (int sx = 0; sx < 8; ++sx)
#pragma unroll
                for (int e = 0; e < 4; ++e) acc = __builtin_amdgcn_mfma_f32_16x16x4f32(av[sx][e], bv[sx][e], acc, 0, 0, 0);
            const f32x4 g4 = *(const f32x4*)(gq + rt * 16 + 4 * fq); const float sc = QK_SCALE * 1.4426950408889634f;
            v2u o; o.x = pkh2(acc[0] * g4[0] * sc, acc[1] * g4[1] * sc); o.y = pkh2(acc[2] * g4[2] * sc, acc[3] * g4[3] * sc);
            *(v2u*)(WQ + (size_t)(h * 128 + ct * 16 + fr) * 256 + rt * 16 + 4 * fq) = o;
        }
    }
    {
        const float* w_uv = P.in[13]; const float* w_o = P.in[14]; bf16* WU = (bf16*)(ws + WS_W_UVO);
        const int fr = F.lane & 15, fq = F.lane >> 4;
        for (int strip = F.gw; strip < 1024; strip += F.NGW) {
            const int h = strip >> 7, ct = (strip >> 4) & 7, ns = strip & 15;
            const float* ap = w_uv + (size_t)(ct * 16 + fr) * 1024 + h * 128 + 4 * fq; const float* bp = w_o + (size_t)(h * 128 + 4 * fq) * 1024 + ns * 64 + fr;
            f32x4 acc[4];
#pragma unroll
            for (int t = 0; t < 4; ++t) acc[t] = (f32x4){0.f, 0.f, 0.f, 0.f};
#pragma unroll 2
            for (int sx = 0; sx < 8; ++sx) { const f32x4 av = *(const f32x4*)(ap + 16 * sx); float bvv[4][4];
#pragma unroll
                for (int e = 0; e < 4; ++e)
#pragma unroll
                    for (int t = 0; t < 4; ++t) bvv[e][t] = bp[(size_t)(16 * sx + e) * 1024 + 16 * t];
#pragma unroll
                for (int e = 0; e < 4; ++e)
#pragma unroll
                    for (int t = 0; t < 4; ++t) acc[t] = __builtin_amdgcn_mfma_f32_16x16x4f32(av[e], bvv[e][t], acc[t], 0, 0, 0); }
#pragma unroll
            for (int t = 0; t < 4; ++t) { v2u o; o.x = pk2(acc[t][0], acc[t][1]); o.y = pk2(acc[t][2], acc[t][3]);
                *(v2u*)(WU + (size_t)(ns * 64 + 16 * t + fr) * 1024 + h * 128 + ct * 16 + 4 * fq) = o; }
        }
    }
    for (int i = F.gw * 64 + F.lane; i < 8 * 8 * 128; i += F.NGW * 64) { const int c16 = i & 127, rr = (i >> 7) & 7, pk = i >> 10;
        v4u z; z.x = 0u; z.y = 0u; z.z = 0u; z.w = 0u; *(v4u*)((bf16*)(ws + WS_FLAT) + ((size_t)(pk * 4096 + 4088 + rr) * 1024 + c16 * 8)) = z; }
    {
        const float* rb = P.in[5]; float* BV = (float*)(ws + WS_BIASV);
        for (int i = F.gw * 64 + F.lane; i < 8 * 8192; i += F.NGW * 64) { const int h = i >> 13, dist = i & 8191; const float v = rb[rel_bucket(dist) * 8 + h]; BV[i] = v; BV[65536 + i] = v * 1.4426950408889634f; }
    }
    ph_norm(F, P.in[0], (bf16*)(ws + WS_XN), true);
}

__device__ __forceinline__ void ph_dsa_prep(const Frame& F, const Params& P) {
    unsigned char* ws = P.ws;
    const float* PROJ = (const float*)(ws + WS_PROJ0); bf16* CQ = (bf16*)(ws + WS_CQ); bf16* CKV = (bf16*)(ws + WS_CKV);
    unsigned short* KIDX = (unsigned short*)(ws + WS_KIDX); float* WIDX = (float*)(ws + WS_WIDX);
    const float* gkv = P.in[8]; const float* gk = P.in[9];
    for (int m = F.gw; m < M; m += F.NGW) {
        const float* p = PROJ + (size_t)m * 512; const int lane = F.lane;
        const f32x4 q = *((const f32x4*)p + lane);
        float s = wave_sum((q.x * q.x + q.y * q.y) + (q.z * q.z + q.w * q.w)); float r = 1.0f / sqrtf(s * (1.f / 256) + 1e-6f);
        v2u w; w.x = pkh2(q.x * r, q.y * r); w.y = pkh2(q.z * r, q.w * r); *((v2u*)(CQ + (size_t)m * 256) + lane) = w;
        const f32x2 c = *((const f32x2*)(p + 256) + lane);
        s = wave_sum(c.x * c.x + c.y * c.y); r = 1.0f / sqrtf(s * (1.f / 128) + 1e-6f);
        *((unsigned*)(CKV + (size_t)m * 128) + lane) = pk2(c.x * r * gkv[2 * lane], c.y * r * gkv[2 * lane + 1]);
        const float k = p[384 + lane];
        s = wave_sum(k * k); r = 1.0f / sqrtf(s * (1.f / 64) + 1e-6f);
        KIDX[(size_t)m * 64 + lane] = f2h(k * r * gk[lane]);
        if (lane < 8) WIDX[(size_t)m * 8 + lane] = p[448 + lane] * WIDX_SCALE;
    }
}

__device__ __forceinline__ unsigned f2key(float f) { const unsigned u = __float_as_uint(f); return (u & 0x80000000u) ? ~u : (u | 0x80000000u); }

typedef _Float16 f16x8 __attribute__((ext_vector_type(8)));
typedef float f32x16 __attribute__((ext_vector_type(16)));
constexpr int IX_C = 496, IX_SOFT = 432, IX_CB_OFF = 16384, IX_FLAG = IX_CB_OFF + 64 * IX_C * 4;

__device__ __forceinline__ void ix_prune8(LAS unsigned char* lds, const unsigned base0, const int (&cnt)[8], const int minc, const int lowbit, const int lane, unsigned (&tau_out)[8], int (&kept)[8]) {
    unsigned e[8][8]; unsigned tau[8];
#pragma unroll
    for (int q = 0; q < 8; ++q) { const LAS unsigned* buf = (const LAS unsigned*)(lds + base0 + (unsigned)q * IX_C * 4); tau[q] = 0u;
#pragma unroll
        for (int i = 0; i < 8; ++i) { const int idx = lane + 64 * i; e[q][i] = (cnt[q] > minc && idx < cnt[q]) ? buf[idx] : 0u; } }
#pragma unroll 1
    for (int bit = 31; bit >= lowbit; --bit) {
#pragma unroll
        for (int q = 0; q < 8; ++q) { const unsigned cand = tau[q] | (1u << bit); int c = 0;
#pragma unroll
            for (int i = 0; i < 8; ++i) c += __popcll(__ballot(e[q][i] >= cand));
            if (c >= 256) tau[q] = cand; }
    }
#pragma unroll
    for (int q = 0; q < 8; ++q) {
        kept[q] = cnt[q]; tau_out[q] = 0u;
        if (cnt[q] > minc) {
            LAS unsigned* buf = (LAS unsigned*)(lds + base0 + (unsigned)q * IX_C * 4); int run = 0;
#pragma unroll
            for (int i = 0; i < 8; ++i) {
                const bool keep = e[q][i] >= tau[q]; const unsigned long long mk = __ballot(keep);
                const int pre = __builtin_amdgcn_mbcnt_hi((unsigned)(mk >> 32), __builtin_amdgcn_mbcnt_lo((unsigned)mk, 0u));
                if (keep) buf[run + pre] = e[q][i];
                run += __popcll(mk);
            }
            kept[q] = run; tau_out[q] = tau[q] == 0u ? 0u : tau[q] - 1u;
        }
    }
}

__device__ __forceinline__ void ph_index_mfma(const Frame& F, const Params& P) {
    unsigned char* ws = P.ws;
    const unsigned short* QIDX = (const unsigned short*)(ws + WS_QIDX); const unsigned short* KIDX = (const unsigned short*)(ws + WS_KIDX);
    const float* WIDX = (const float*)(ws + WS_WIDX); unsigned short* SEL = (unsigned short*)(ws + WS_SEL);
    const int tid = F.tid, lane = F.lane, w = F.wave, hi = lane >> 5, l31 = lane & 31;
    const int a_hr = (l31 >> 2) & 1, a_i = (l31 & 3) + 4 * (l31 >> 3), a_q = 2 * a_hr + (a_i >> 3), a_h = a_i & 7;
    const int st_key = tid >> 3, st_c = tid & 7, st_off = st_key * 128 + ((st_c ^ ((st_key >> 1) & 7)) * 16);
    LAS unsigned* flags = (LAS unsigned*)(F.lds + IX_FLAG);
    for (int p = blockIdx.x; p < 256; p += F.G) {
#pragma unroll 1
        for (int h2 = 0; h2 < 2; ++h2) {
            const int b = p >> 6, jt = h2 ? 127 - (p & 63) : (p & 63), t0 = jt * 64, m0 = b * T + t0;
            f16x8 A[2][4]; float wr[2][16];
#pragma unroll
            for (int g = 0; g < 2; ++g) {
#pragma unroll
                for (int ks = 0; ks < 4; ++ks) A[g][ks] = *(const f16x8*)(QIDX + (size_t)(m0 + w * 8 + 4 * g + a_q) * 512 + a_h * 64 + 16 * ks + 8 * hi);
#pragma unroll
                for (int j = 0; j < 2; ++j) { const f32x4* wp = (const f32x4*)(WIDX + (size_t)(m0 + w * 8 + 4 * g + 2 * hi + j) * 8); const f32x4 x = wp[0], y = wp[1];
                    wr[g][8 * j + 0] = x.x; wr[g][8 * j + 1] = x.y; wr[g][8 * j + 2] = x.z; wr[g][8 * j + 3] = x.w; wr[g][8 * j + 4] = y.x; wr[g][8 * j + 5] = y.y; wr[g][8 * j + 6] = y.z; wr[g][8 * j + 7] = y.w; }
            }
            f16x8 AL[4];
            {
                float al[4][8];
#pragma unroll
                for (int ks = 0; ks < 4; ++ks)
#pragma unroll
                    for (int j = 0; j < 8; ++j) al[ks][j] = 0.f;
                if (l31 < 8) {
                    const int lq = 4 * ((l31 & 3) >> 1) + 2 * ((l31 >> 2) & 1) + (l31 & 1);
                    const f32x4* wp = (const f32x4*)(WIDX + (size_t)(m0 + w * 8 + lq) * 8); const f32x4 wx = wp[0], wy = wp[1];
                    const float wq[8] = {wx.x, wx.y, wx.z, wx.w, wy.x, wy.y, wy.z, wy.w};
#pragma unroll
                    for (int h = 0; h < 8; ++h)
#pragma unroll
                        for (int ks = 0; ks < 4; ++ks) { const f16x8 qv = *(const f16x8*)(QIDX + (size_t)(m0 + w * 8 + lq) * 512 + h * 64 + 16 * ks + 8 * hi);
#pragma unroll
                            for (int j = 0; j < 8; ++j) al[ks][j] += wq[h] * (float)qv[j]; }
                }
#pragma unroll
                for (int ks = 0; ks < 4; ++ks)
#pragma unroll
                    for (int j = 0; j < 8; ++j) AL[ks][j] = (_Float16)al[ks][j];
            }
            unsigned tauV[4], posV[4], tinv[4];
#pragma unroll
            for (int sl = 0; sl < 4; ++sl) { const int ql = 4 * (sl >> 1) + 2 * hi + (sl & 1); const unsigned base = IX_CB_OFF + (unsigned)(w * 8 + ql) * IX_C * 4;
                tauV[sl] = 0u; posV[sl] = base; tinv[sl] = 8191u - (unsigned)(t0 + w * 8 + ql); }
            const int nch = jt + 1;
            const unsigned short* kbase = KIDX + (size_t)(b * T) * 64 + (size_t)st_key * 64 + st_c * 8;
            v4u kreg = *(const v4u*)kbase;
            *(LAS v4u*)(F.lds + st_off) = kreg;
            if (tid < 128) flags[tid] = 0u;
            __syncthreads();
#pragma unroll 1
            for (int ch = 0; ch < nch; ++ch) {
                if (ch + 1 < nch) kreg = *(const v4u*)(kbase + (size_t)(ch + 1) * 64 * 64);
                const bool lastc = (ch == jt);
                LAS unsigned char* kb_lds = F.lds + (ch & 1) * 8192;
                const int ntile = (lastc && (32 > 8 * w + 7)) ? 1 : 2;
                f16x8 kfa[4], kfb[4];
                { const unsigned kbase = (unsigned)(uintptr_t)kb_lds + (unsigned)l31 * 128u; const unsigned ksw = ((unsigned)l31 >> 1) & 7u;
                  const unsigned a0 = kbase + (((0u + hi) ^ ksw) * 16u), a1 = kbase + (((2u + hi) ^ ksw) * 16u), a2 = kbase + (((4u + hi) ^ ksw) * 16u), a3 = kbase + (((6u + hi) ^ ksw) * 16u);
                  asm volatile("ds_read_b128 %0, %8\n\tds_read_b128 %1, %9\n\tds_read_b128 %2, %10\n\tds_read_b128 %3, %11\n\t"
                               "ds_read_b128 %4, %8 offset:4096\n\tds_read_b128 %5, %9 offset:4096\n\tds_read_b128 %6, %10 offset:4096\n\tds_read_b128 %7, %11 offset:4096"
                               : "=&v"(kfa[0]), "=&v"(kfa[1]), "=&v"(kfa[2]), "=&v"(kfa[3]), "=&v"(kfb[0]), "=&v"(kfb[1]), "=&v"(kfb[2]), "=&v"(kfb[3]) : "v"(a0), "v"(a1), "v"(a2), "v"(a3) : "memory");
                  asm volatile("s_waitcnt lgkmcnt(0)" : "+v"(kfa[0]), "+v"(kfa[1]), "+v"(kfa[2]), "+v"(kfa[3]), "+v"(kfb[0]), "+v"(kfb[1]), "+v"(kfb[2]), "+v"(kfb[3]) :: "memory"); }
#pragma unroll
                for (int tile = 0; tile < 2; ++tile) {
                    if (tile >= ntile) break;
                    const int key = tile * 32 + l31;
                    f16x8 kf[4];
#pragma unroll
                    for (int ks = 0; ks < 4; ++ks) kf[ks] = tile == 0 ? kfa[ks] : kfb[ks];
                    const unsigned invidx = 8191u - (unsigned)(64 * ch + key);
                    f32x16 accl, acc2[2];
#pragma unroll
                    for (int i = 0; i < 16; ++i) { accl[i] = 0.f; acc2[0][i] = 0.f; acc2[1][i] = 0.f; }
#pragma unroll
                    for (int ks = 0; ks < 4; ++ks) {
                        accl = __builtin_amdgcn_mfma_f32_32x32x16_f16(AL[ks], kf[ks], accl, 0, 0, 0);
                        acc2[0] = __builtin_amdgcn_mfma_f32_32x32x16_f16(A[0][ks], kf[ks], acc2[0], 0, 0, 0);
                        acc2[1] = __builtin_amdgcn_mfma_f32_32x32x16_f16(A[1][ks], kf[ks], acc2[1], 0, 0, 0);
                    }
                    __builtin_amdgcn_sched_barrier(0);
#pragma unroll
                    for (int g = 0; g < 2; ++g) {
#pragma unroll
                        for (int v = 0; v < 2; ++v) {
                            const int sl = 2 * g + v;
                            float s = accl[sl];
#pragma unroll
                            for (int i = 0; i < 8; ++i) s = __builtin_fmaf(__builtin_fabsf(acc2[g][8 * v + i]), wr[g][8 * v + i], s);
                            unsigned u = __float_as_uint(s); u ^= ((unsigned)((int)u >> 31) | 0x80000000u);
                            unsigned kk = (u & 0xFFFFE000u) | invidx;
                            if (lastc) kk = (invidx >= tinv[sl]) ? kk : 0u;
                            const bool pass = kk > tauV[sl];
                            const unsigned long long mk = __ballot(pass);
                            if (mk != 0ull) {
                                const unsigned mlo = (unsigned)mk, mhi = (unsigned)(mk >> 32);
                                const int nlo = __popc(mlo), nhi = __popc(mhi);
                                const int pre = __builtin_amdgcn_mbcnt_hi(mhi, __builtin_amdgcn_mbcnt_lo(mlo, 0u)) - (hi ? nlo : 0);
                                if (pass) *(LAS unsigned*)(F.lds + posV[sl] + 4u * (unsigned)pre) = kk;
                                posV[sl] += 4u * (unsigned)(hi ? nhi : nlo);
                            }
                        }
                    }
                }
                {
                    bool ov = false;
#pragma unroll
                    for (int sl = 0; sl < 4; ++sl) { const int ql = 4 * (sl >> 1) + 2 * hi + (sl & 1); ov |= posV[sl] > IX_CB_OFF + (unsigned)(w * 8 + ql) * IX_C * 4 + IX_SOFT * 4; }
                    if (__ballot(ov) != 0ull && lane == 0) flags[ch] = 1u;
                }
                if (ch + 1 < nch) *(LAS v4u*)(F.lds + ((ch + 1) & 1) * 8192 + st_off) = kreg;
                __syncthreads();
                if (flags[ch] != 0u) {
                    int cntq[8]; unsigned tq8[8]; int kq[8];
#pragma unroll
                    for (int sl = 0; sl < 4; ++sl)
#pragma unroll
                        for (int hf = 0; hf < 2; ++hf) { const int ql = 4 * (sl >> 1) + 2 * hf + (sl & 1);
                            cntq[ql] = (int)((unsigned)__builtin_amdgcn_readlane((int)posV[sl], 32 * hf) - (IX_CB_OFF + (unsigned)(w * 8 + ql) * IX_C * 4)) >> 2; }
                    ix_prune8(F.lds, IX_CB_OFF + (unsigned)(w * 8) * IX_C * 4, cntq, 288, 17, lane, tq8, kq);
                    { bool big = false;
#pragma unroll
                      for (int q = 0; q < 8; ++q) big |= (cntq[q] > 288) && (kq[q] > 400);
                      if (big) { int c2[8]; unsigned t2[8]; int k2[8];
#pragma unroll
                          for (int q = 0; q < 8; ++q) c2[q] = cntq[q] > 288 ? kq[q] : 0;
                          ix_prune8(F.lds, IX_CB_OFF + (unsigned)(w * 8) * IX_C * 4, c2, 288, 0, lane, t2, k2);
#pragma unroll
                          for (int q = 0; q < 8; ++q) if (c2[q] > 288) { tq8[q] = t2[q]; kq[q] = k2[q]; } } }
#pragma unroll
                    for (int sl = 0; sl < 4; ++sl)
#pragma unroll
                        for (int hf = 0; hf < 2; ++hf) { const int ql = 4 * (sl >> 1) + 2 * hf + (sl & 1);
                            if (cntq[ql] > 288 && hi == hf) { tauV[sl] = tq8[ql]; posV[sl] = IX_CB_OFF + (unsigned)(w * 8 + ql) * IX_C * 4 + 4u * (unsigned)kq[ql]; } }
                }
            }
            {
                int cntq[8]; unsigned tq8[8]; int kq[8];
#pragma unroll
                for (int sl = 0; sl < 4; ++sl)
#pragma unroll
                    for (int hf = 0; hf < 2; ++hf) { const int ql = 4 * (sl >> 1) + 2 * hf + (sl & 1);
                        cntq[ql] = (int)((unsigned)__builtin_amdgcn_readlane((int)posV[sl], 32 * hf) - (IX_CB_OFF + (unsigned)(w * 8 + ql) * IX_C * 4)) >> 2; }
                ix_prune8(F.lds, IX_CB_OFF + (unsigned)(w * 8) * IX_C * 4, cntq, 256, 0, lane, tq8, kq);
#pragma unroll
                for (int ql = 0; ql < 8; ++ql) {
                    const LAS unsigned* buf = (const LAS unsigned*)(F.lds + IX_CB_OFF + (unsigned)(w * 8 + ql) * IX_C * 4);
                    const int cnt = kq[ql];
                    unsigned short* out = SEL + (size_t)(m0 + w * 8 + ql) * 256;
#pragma unroll
                    for (int i = 0; i < 4; ++i) { const int idx = lane + 64 * i; out[idx] = idx < cnt ? (unsigned short)(8191u - (buf[idx] & 0x1FFFu)) : (unsigned short)0xFFFF; }
                }
            }
            __syncthreads();
        }
    }
}

__device__ __forceinline__ void ph_cmp_gather(const Frame& F, const Params& P) {
    unsigned char* ws = P.ws; const bf16* KV = (const bf16*)(ws + WS_KV); bf16* FLAT = (bf16*)(ws + WS_FLAT);
    const int NIT = 2 * 4096 * 16;
    for (int it = F.gw; it < NIT; it += F.NGW) {
        const int jp = it & 15, row = (it >> 4) & 4095, part = it >> 16;
        const int j = jp * 2 + (F.lane >> 5), d = (F.lane & 31) * 4;
        const int k = j * 128 + d, ks = k >> 10, kk = k & 1023;
        v2u o; o.x = 0u; o.y = 0u;
        if (row < 4088) {
            const int g = row & 1, bn = row >> 1, n = bn % NCMP, b = bn / NCMP;
            const v2u w = *(const v2u*)(KV + (size_t)(b * T + 16 * n + j) * KVW + part * 256 + g * 128 + d);
            const f32x4 pp = *(const f32x4*)(P.in[part ? 18 : 17] + j * 128 + d);
            o.x = pk2(bflo(w.x) + pp.x, bfhi(w.x) + pp.y); o.y = pk2(bflo(w.y) + pp.z, bfhi(w.y) + pp.w);
        }
        *(v2u*)(FLAT + (((size_t)(part * 4 + ks) * 4096 + row) * 1024 + kk)) = o;
    }
}
struct CmpOrder {
    int G, c;
    __device__ bool next(int i, pg8::Unit& u) const { const int L = i * G + c; if (L >= 128) return false; u.pm = L; u.pn = L >> 4; return true; }
    __device__ __forceinline__ void a_ready(const pg8::Unit&) const {}
    __device__ __forceinline__ void done(const pg8::Unit&) const {}
};
struct GateOrder {
    int G, c;
    __device__ bool next(int i, pg8::Unit& u) const { const int i0 = c >= 128 ? 0 : (128 - c + G - 1) / G; const int L = (i0 + i) * G + c; if (L >= 256) return false; u.pm = L - 128; u.pn = 0; return true; }
    __device__ __forceinline__ void a_ready(const pg8::Unit&) const {}
    __device__ __forceinline__ void done(const pg8::Unit&) const {}
};
__device__ __forceinline__ void ph_cmp_reduce(const Frame& F, const Params& P) {
    unsigned char* ws = P.ws; const float* PART = (const float*)(ws + WS_PART);
    LAS float* w2s = (LAS float*)F.lds;
    LAS float* hid = (LAS float*)(F.lds + 131072) + F.wave * 256;
    const int half = F.G / 2;
    for (int pc = blockIdx.x; pc < 2 * half; pc += F.G) {
        const int part = pc >= half ? 1 : 0, wgi = part ? pc - half : pc;
        const float* w2 = P.in[part ? 22 : 20]; bf16* OUT = (bf16*)(ws + (part ? WS_VC : WS_KC));
        __syncthreads();
        for (int i = F.tid; i < 256 * 128 / 4; i += NTHR) ((LAS f32x4*)w2s)[i] = ((const f32x4*)w2)[i];
        __syncthreads();
        for (int row = wgi * NWAVES + F.wave; row < 4096; row += half * NWAVES) {
            if (row >= 4088) {
                const int pr = row - 4088, pb = pr >> 1, pg = pr & 1; *((unsigned*)(OUT + ((size_t)(pb * 512 + 511) * 2 + pg) * 128) + F.lane) = 0u; continue; }
            const int orow_ = ((row >> 1) / NCMP * 512 + (row >> 1) % NCMP) * 2 + (row & 1);
            f32x4 sacc = {0.f, 0.f, 0.f, 0.f};
#pragma unroll
            for (int ks = 0; ks < 4; ++ks) sacc += *((const f32x4*)(PART + ((size_t)(part * 4 + ks) * 4096 + row) * 256) + F.lane);
#pragma unroll
            for (int e = 0; e < 4; ++e) { const float v = sacc[e]; const float u = 0.7978845608028654f * (v + 0.044715f * v * v * v); hid[F.lane * 4 + e] = 0.5f * v * (1.0f + tanhf(u)); }
            LDS_WAIT(); asm volatile("" ::: "memory");
            float a0 = 0.f, a1 = 0.f;
#pragma unroll 8
            for (int j = 0; j < 256; ++j) { const float hj = hid[j]; const f32x2 wv = *((const LAS f32x2*)(w2s + j * 128) + F.lane); a0 += hj * wv.x; a1 += hj * wv.y; }
            *((unsigned*)(OUT + (size_t)orow_ * 128) + F.lane) = pk2(a0, a1);
            LDS_WAIT(); asm volatile("" ::: "memory");
        }
    }
}

typedef short bf16x8v __attribute__((ext_vector_type(8)));
typedef short s16x4v __attribute__((ext_vector_type(4)));
typedef __bf16 bf16x2_t __attribute__((ext_vector_type(2)));
constexpr float LOG2E = 1.4426950408889634f;
constexpr float NS_FLOOR = -10000.f;
constexpr int NS_K = 0, NS_V = 49152, NS_T = 98304, NS_TBUF = 2304, NS_TROW = 544, NS_NEG = 98304 + 3 * NS_TBUF, NS_IMP = 106496, NS_IMPROW = 132, NS_WM = NS_IMP + 8 * 8 * NS_IMPROW * 4, NS_GATE = NS_WM + 128 + 1024;
__device__ __forceinline__ unsigned cvtpk(float lo, float hi) { const f32x2 v = {lo, hi}; const bf16x2_t b = __builtin_convertvector(v, bf16x2_t); return __builtin_bit_cast(unsigned, b); }
__device__ __forceinline__ float swap32_max(float m) { const auto rr = __builtin_amdgcn_permlane32_swap(__float_as_uint(m), __float_as_uint(m), false, false); return fmaxf(__uint_as_float(rr[0]), __uint_as_float(rr[1])); }
__device__ __forceinline__ float swap32_sum(float m) { const auto rr = __builtin_amdgcn_permlane32_swap(__float_as_uint(m), __float_as_uint(m), false, false); return __uint_as_float(rr[0]) + __uint_as_float(rr[1]); }
__device__ __forceinline__ float quad_sum(float x) {
    x += __builtin_bit_cast(float, __builtin_amdgcn_update_dpp(0, __builtin_bit_cast(int, x), 0xB1, 0xF, 0xF, false));
    x += __builtin_bit_cast(float, __builtin_amdgcn_update_dpp(0, __builtin_bit_cast(int, x), 0x4E, 0xF, 0xF, false));
    return x;
}
__device__ __forceinline__ bf16x8v ns_vfrag(const LAS unsigned char* p0, const LAS unsigned char* p1) {
    const s16x4v lo = __builtin_bit_cast(s16x4v, __builtin_amdgcn_ds_read_tr16_b64_v4i16((LAS s16x4v*)p0));
    const s16x4v hi = __builtin_bit_cast(s16x4v, __builtin_amdgcn_ds_read_tr16_b64_v4i16((LAS s16x4v*)p1));
    return (bf16x8v){lo[0], lo[1], lo[2], lo[3], hi[0], hi[1], hi[2], hi[3]};
}
__device__ __forceinline__ float max3f(float a, float b, float c) { float r; asm("v_max3_f32 %0, %1, %2, %3" : "=v"(r) : "v"(a), "v"(b), "v"(c)); return r; }
__device__ __forceinline__ void lds_rd4_b128(bf16x8v (&f)[4], const unsigned a0, const unsigned a1) {
    asm volatile("ds_read_b128 %0, %4\n\tds_read_b128 %1, %4 offset:8192\n\tds_read_b128 %2, %5\n\tds_read_b128 %3, %5 offset:8192"
                 : "=&v"(f[0]), "=&v"(f[1]), "=&v"(f[2]), "=&v"(f[3]) : "v"(a0), "v"(a1) : "memory");
}
template <int N> __device__ __forceinline__ void lds_wait4(bf16x8v (&f)[4]) { asm volatile("s_waitcnt lgkmcnt(%4)" : "+v"(f[0]), "+v"(f[1]), "+v"(f[2]), "+v"(f[3]) : "n"(N) : "memory"); }
template <int OFF> __device__ __forceinline__ void lds_rdtr4(v2u (&lo)[4], v2u (&hi)[4], const unsigned (&va)[4][2]) {
    asm volatile("ds_read_b64_tr_b16 %0, %8 offset:%16\n\tds_read_b64_tr_b16 %1, %9 offset:%16\n\tds_read_b64_tr_b16 %2, %10 offset:%16\n\tds_read_b64_tr_b16 %3, %11 offset:%16\n\t"
                 "ds_read_b64_tr_b16 %4, %12 offset:%16\n\tds_read_b64_tr_b16 %5, %13 offset:%16\n\tds_read_b64_tr_b16 %6, %14 offset:%16\n\tds_read_b64_tr_b16 %7, %15 offset:%16"
                 : "=&v"(lo[0]), "=&v"(hi[0]), "=&v"(lo[1]), "=&v"(hi[1]), "=&v"(lo[2]), "=&v"(hi[2]), "=&v"(lo[3]), "=&v"(hi[3])
                 : "v"(va[0][0]), "v"(va[0][1]), "v"(va[1][0]), "v"(va[1][1]), "v"(va[2][0]), "v"(va[2][1]), "v"(va[3][0]), "v"(va[3][1]), "n"(OFF) : "memory");
}
template <int N> __device__ __forceinline__ void lds_wait8(v2u (&lo)[4], v2u (&hi)[4]) {
    asm volatile("s_waitcnt lgkmcnt(%8)" : "+v"(lo[0]), "+v"(hi[0]), "+v"(lo[1]), "+v"(hi[1]), "+v"(lo[2]), "+v"(hi[2]), "+v"(lo[3]), "+v"(hi[3]) : "n"(N) : "memory");
}
__device__ __forceinline__ bf16x8v vcat(const v2u lo, const v2u hi) { v4u t; t.x = lo.x; t.y = lo.y; t.z = hi.x; t.w = hi.y; return __builtin_bit_cast(bf16x8v, t); }
template <int MODE, int COFS>
__device__ __forceinline__ void ns_half(f32x16& S, const unsigned (&va)[4][2], const float sub, float& l_run, f32x16 (&O)[4], const float inv_l, LAS float* improw, const int jblk, const int r) {
    v2u vlo0[4], vhi0[4], vlo1[4], vhi1[4];
    if (MODE != 1) {
#pragma unroll
        for (int i = 0; i < 16; ++i) { S[i] = __builtin_amdgcn_exp2f(S[i] - sub); l_run += S[i]; }
    } else {
#pragma unroll
        for (int i = 0; i < 16; ++i) S[i] = __builtin_amdgcn_exp2f(S[i] - sub) * inv_l;
#pragma unroll
        for (int a = 0; a < 4; ++a) {
            const float mainv = quad_sum((S[4 * a] + S[4 * a + 1]) + (S[4 * a + 2] + 0.5f * S[4 * a + 3])), sidev = quad_sum(0.5f * S[4 * a + 3]);
            if (r == 0) { LAS float* ip = improw + jblk + 2 * a;
                __hip_atomic_fetch_add(ip, mainv, __ATOMIC_RELAXED, __HIP_MEMORY_SCOPE_WORKGROUP); __hip_atomic_fetch_add(ip + 1, sidev, __ATOMIC_RELAXED, __HIP_MEMORY_SCOPE_WORKGROUP); }
        }
    }
    if (MODE == 0) return;
    v4u pw0, pw1;
    pw0.x = cvtpk(S[0], S[1]); pw0.y = cvtpk(S[2], S[3]); pw0.z = cvtpk(S[4], S[5]); pw0.w = cvtpk(S[6], S[7]);
    pw1.x = cvtpk(S[8], S[9]); pw1.y = cvtpk(S[10], S[11]); pw1.z = cvtpk(S[12], S[13]); pw1.w = cvtpk(S[14], S[15]);
    const bf16x8v pf0 = __builtin_bit_cast(bf16x8v, pw0), pf1 = __builtin_bit_cast(bf16x8v, pw1);
    lds_rdtr4<4096 * (COFS >> 4)>(vlo0, vhi0, va);
    lds_rdtr4<4096 * (COFS >> 4) + 4096>(vlo1, vhi1, va);
    lds_wait8<8>(vlo0, vhi0);
#pragma unroll
    for (int ct = 0; ct < 4; ++ct) O[ct] = __builtin_amdgcn_mfma_f32_32x32x16_bf16(vcat(vlo0[ct], vhi0[ct]), pf0, O[ct], 0, 0, 0);
    lds_wait8<0>(vlo1, vhi1);
#pragma unroll
    for (int ct = 0; ct < 4; ++ct) O[ct] = __builtin_amdgcn_mfma_f32_32x32x16_bf16(vcat(vlo1[ct], vhi1[ct]), pf1, O[ct], 0, 0, 0);
}
template <int MODE>
__device__ __forceinline__ void ns_tile(LAS unsigned char* lds, const int kb, const int vb, const unsigned tbase, const bool constb, const bf16x8v (&Qf)[8], const unsigned kbase0, const unsigned vbase0,
                                        const bool edge, const int bl, const int bh, float& m_run, float& l_run, f32x16 (&O)[4], const float inv_l, LAS float* improw, const int jblk0, const int r,
                                        const float cb = 0.f, const bool dead = false) {
    f32x16 S0, S1;
    const unsigned ldsb = (unsigned)(uintptr_t)lds;
    const unsigned kt = ldsb + (unsigned)kb;
    if (MODE == 2 && !constb) { const LAS float* Tl = (const LAS float*)(lds + tbase);
#pragma unroll
        for (int i = 0; i < 16; ++i) { S0[i] = Tl[(i & 3) + 8 * (i >> 2)]; S1[i] = Tl[(i & 3) + 8 * (i >> 2) + 32]; }
    } else {
#pragma unroll
        for (int i = 0; i < 16; ++i) { S0[i] = 0.f; S1[i] = 0.f; }
    }
    bf16x8v fa[4], fb[4];
    lds_rd4_b128(fa, kt + kbase0, kt + (kbase0 ^ 32u));
    lds_rd4_b128(fb, kt + (kbase0 ^ 64u), kt + (kbase0 ^ 96u));
    lds_wait4<4>(fa);
    S0 = __builtin_amdgcn_mfma_f32_32x32x16_bf16(fa[0], Qf[0], S0, 0, 0, 0); S1 = __builtin_amdgcn_mfma_f32_32x32x16_bf16(fa[1], Qf[0], S1, 0, 0, 0);
    S0 = __builtin_amdgcn_mfma_f32_32x32x16_bf16(fa[2], Qf[1], S0, 0, 0, 0); S1 = __builtin_amdgcn_mfma_f32_32x32x16_bf16(fa[3], Qf[1], S1, 0, 0, 0);
    __builtin_amdgcn_sched_barrier(0);
    lds_rd4_b128(fa, kt + (kbase0 ^ 128u), kt + (kbase0 ^ 160u));
    lds_wait4<4>(fb);
    S0 = __builtin_amdgcn_mfma_f32_32x32x16_bf16(fb[0], Qf[2], S0, 0, 0, 0); S1 = __builtin_amdgcn_mfma_f32_32x32x16_bf16(fb[1], Qf[2], S1, 0, 0, 0);
    S0 = __builtin_amdgcn_mfma_f32_32x32x16_bf16(fb[2], Qf[3], S0, 0, 0, 0); S1 = __builtin_amdgcn_mfma_f32_32x32x16_bf16(fb[3], Qf[3], S1, 0, 0, 0);
    __builtin_amdgcn_sched_barrier(0);
    lds_rd4_b128(fb, kt + (kbase0 ^ 192u), kt + (kbase0 ^ 224u));
    lds_wait4<4>(fa);
    S0 = __builtin_amdgcn_mfma_f32_32x32x16_bf16(fa[0], Qf[4], S0, 0, 0, 0); S1 = __builtin_amdgcn_mfma_f32_32x32x16_bf16(fa[1], Qf[4], S1, 0, 0, 0);
    S0 = __builtin_amdgcn_mfma_f32_32x32x16_bf16(fa[2], Qf[5], S0, 0, 0, 0); S1 = __builtin_amdgcn_mfma_f32_32x32x16_bf16(fa[3], Qf[5], S1, 0, 0, 0);
    __builtin_amdgcn_sched_barrier(0);
    unsigned va[4][2];
    { const unsigned vt = ldsb + (unsigned)vb;
#pragma unroll
      for (int ct = 0; ct < 4; ++ct) { va[ct][0] = vt + (vbase0 ^ (64u * ct)); va[ct][1] = vt + ((vbase0 ^ (64u * ct)) ^ 2080u); } }
    lds_wait4<0>(fb);
    S0 = __builtin_amdgcn_mfma_f32_32x32x16_bf16(fb[0], Qf[6], S0, 0, 0, 0); S1 = __builtin_amdgcn_mfma_f32_32x32x16_bf16(fb[1], Qf[6], S1, 0, 0, 0);
    S0 = __builtin_amdgcn_mfma_f32_32x32x16_bf16(fb[2], Qf[7], S0, 0, 0, 0); S1 = __builtin_amdgcn_mfma_f32_32x32x16_bf16(fb[3], Qf[7], S1, 0, 0, 0);
    __builtin_amdgcn_sched_barrier(0);
    if (edge) {
#pragma unroll
        for (int i = 0; i < 16; ++i) { const int c0 = (i & 3) + 8 * (i >> 2), c1 = c0 + 32;
            S0[i] = (c0 >= bl && c0 <= bh) ? S0[i] : NEGF; S1[i] = (c1 >= bl && c1 <= bh) ? S1[i] : NEGF; }
    }
    float sub = m_run;
    if (MODE != 1) {
        if (!edge) asm volatile("s_nop 7\n\ts_nop 7" ::: );
        float mx = max3f(S0[0], S0[1], S0[2]);
#pragma unroll
        for (int i = 3; i < 15; i += 2) mx = max3f(mx, S0[i], S0[i + 1]);
#pragma unroll
        for (int i = 0; i < 16; i += 2) mx = max3f(mx, S1[i], S1[i + 1]);
        mx = fmaxf(mx, S0[15]);
        mx = swap32_max(mx) + cb;
        if (__ballot(!dead && (mx > m_run + 60.f)) != 0ull) {
            const float m_new = dead ? m_run : fmaxf(m_run, mx);
            const float sc = __builtin_amdgcn_exp2f(m_run - m_new); l_run *= sc;
            if (MODE == 2) {
#pragma unroll
                for (int ct = 0; ct < 4; ++ct)
#pragma unroll
                    for (int i = 0; i < 16; ++i) O[ct][i] *= sc;
            }
            m_run = m_new;
        }
        sub = dead ? 1e30f : (m_run - cb);
    }
    ns_half<MODE, 0>(S0, va, sub, l_run, O, inv_l, improw, jblk0, r);
    __builtin_amdgcn_sched_barrier(0);
    ns_half<MODE, 32>(S1, va, sub, l_run, O, inv_l, improw, jblk0 + 8, r);
}
__device__ __forceinline__ void ns_emit(bf16* orow, const f32x16 (&O)[4], const float scale, const int hi, const bool accumulate) {
#pragma unroll
    for (int ct = 0; ct < 4; ++ct)
#pragma unroll
        for (int a = 0; a < 4; ++a) {
            v2u* p = (v2u*)(orow + 32 * ct + 8 * a + 4 * hi);
            float x0 = O[ct][4 * a] * scale, x1 = O[ct][4 * a + 1] * scale, x2 = O[ct][4 * a + 2] * scale, x3 = O[ct][4 * a + 3] * scale;
            if (accumulate) { const v2u old = *p; x0 += bflo(old.x); x1 += bfhi(old.x); x2 += bflo(old.y); x3 += bfhi(old.y); }
            v2u o; o.x = cvtpk(x0, x1); o.y = cvtpk(x2, x3); *p = o;
        }
}
__device__ __forceinline__ void ns_emit_rows(LAS unsigned char* lds, const int w, const int b0, const int b1, bf16* obase, const f32x16 (&O)[4], const float scale, const int lane, const bool accumulate) {
    const int l31 = lane & 31, hi = lane >> 5;
#define NS_PIECE(R_) ((unsigned)(NS_K + ((R_) >> 4) * (NS_V - NS_K) + ((((R_) >> 3) & 1) ? b1 : b0) * 16384 + w * 2048 + ((R_) & 7) * 256))
    { LAS unsigned char* wrow = lds + NS_PIECE(l31) + hi * 8; const unsigned sw = (unsigned)(l31 & 15);
#pragma unroll
      for (int ct = 0; ct < 4; ++ct)
#pragma unroll
          for (int a = 0; a < 4; ++a) { v2u o; o.x = cvtpk(O[ct][4 * a] * scale, O[ct][4 * a + 1] * scale); o.y = cvtpk(O[ct][4 * a + 2] * scale, O[ct][4 * a + 3] * scale);
              *(LAS v2u*)(wrow + (((unsigned)(4 * ct + a) ^ sw) << 4)) = o; } }
    LDS_WAIT(); asm volatile("" ::: "memory");
    const int j = lane & 15;
    v4u nw[8], od[8];
#pragma unroll
    for (int k = 0; k < 8; ++k) { const int R = 4 * k + (lane >> 4);
        nw[k] = *(const LAS v4u*)(lds + NS_PIECE(R) + (((unsigned)j ^ (unsigned)(R & 15)) << 4));
        if (accumulate) od[k] = *(const v4u*)(obase + (size_t)(R >> 2) * 1024 + (R & 3) * 128 + 8 * j); }
#pragma unroll
    for (int k = 0; k < 8; ++k) { const int R = 4 * k + (lane >> 4); v4u o = nw[k];
        if (accumulate) {
            o.x = cvtpk(bflo(nw[k].x) + bflo(od[k].x), bfhi(nw[k].x) + bfhi(od[k].x)); o.y = cvtpk(bflo(nw[k].y) + bflo(od[k].y), bfhi(nw[k].y) + bfhi(od[k].y));
            o.z = cvtpk(bflo(nw[k].z) + bflo(od[k].z), bfhi(nw[k].z) + bfhi(od[k].z)); o.w = cvtpk(bflo(nw[k].w) + bflo(od[k].w), bfhi(nw[k].w) + bfhi(od[k].w)); }
        *(v4u*)(obase + (size_t)(R >> 2) * 1024 + (R & 3) * 128 + 8 * j) = o; }
#undef NS_PIECE
}
__device__ __forceinline__ int ns_next_bit(const unsigned m0, const unsigned m1, const unsigned m2, const unsigned m3, const int from) {
    if (from >= 128) return 128;
    const int wd = from >> 5; const unsigned lowm = 0xFFFFFFFFu << (from & 31);
    unsigned x;
    x = (wd == 0) ? (m0 & lowm) : 0u; if (x) return __builtin_ctz(x);
    x = (wd == 1) ? (m1 & lowm) : (wd < 1 ? m1 : 0u); if (x) return 32 + __builtin_ctz(x);
    x = (wd == 2) ? (m2 & lowm) : (wd < 2 ? m2 : 0u); if (x) return 64 + __builtin_ctz(x);
    x = (wd == 3) ? (m3 & lowm) : m3; if (x) return 96 + __builtin_ctz(x);
    return 128;
}

__device__ __forceinline__ void ph_nsa_attn_flash(const Frame& F, const Params& P) {
    unsigned char* ws = P.ws;
    const bf16* QN = (const bf16*)(ws + WS_QN); const bf16* KV = (const bf16*)(ws + WS_KV); const bf16* KC = (const bf16*)(ws + WS_KC); const bf16* VC = (const bf16*)(ws + WS_VC);
    const float* GATES = (const float*)(ws + WS_GATES); const float* BV = (const float*)(ws + WS_BIASV); bf16* ONSA = (bf16*)(ws + WS_XN);
    LAS unsigned char* lds = F.lds;
    const int tid = F.tid, lane = F.lane, w = F.wave, hi = lane >> 5, l31 = lane & 31, qi = l31 >> 2, r = l31 & 3, qoff = w * 8 + qi;
    for (int i = tid; i < 256; i += NTHR) ((LAS float*)(lds + NS_NEG))[i] = NEGF;
    LAS float* improw = (LAS float*)(lds + NS_IMP) + (w * 8 + qi) * NS_IMPROW;
#define NS_OFF(i_, stride_) ((8u * w + 4u * (i_) + ((unsigned)lane >> 4)) * (stride_) + ((((unsigned)lane & 15u) ^ ((((unsigned)lane >> 4) << 2) | ((2u * w + (i_)) & 3u))) * 8u))
#define okv0 NS_OFF(0u, (unsigned)KVW)
#define okv1 NS_OFF(1u, (unsigned)KVW)
#define oc0 NS_OFF(0u, 256u)
#define oc1 NS_OFF(1u, 256u)
    const float* BV2 = BV + 65536;
#define NS_DMA_KV(kp, vp, o0, o1, buf) do { \
        __builtin_amdgcn_global_load_lds((const unsigned*)((kp) + (o0)), (LAS unsigned*)(lds + NS_K + (buf) * 16384 + w * 2048), 16, 0, 0); \
        __builtin_amdgcn_global_load_lds((const unsigned*)((kp) + (o1)), (LAS unsigned*)(lds + NS_K + (buf) * 16384 + w * 2048 + 1024), 16, 0, 0); \
        __builtin_amdgcn_global_load_lds((const unsigned*)((vp) + (o0)), (LAS unsigned*)(lds + NS_V + (buf) * 16384 + w * 2048), 16, 0, 0); \
        __builtin_amdgcn_global_load_lds((const unsigned*)((vp) + (o1)), (LAS unsigned*)(lds + NS_V + (buf) * 16384 + w * 2048 + 1024), 16, 0, 0); } while (0)
#define NS_DMA_T(js, buf) do { int dist_ = 64 * (jt - (js)) + 63 - (64 * (w & 1) + lane); dist_ = dist_ < 0 ? 0 : dist_; \
        __builtin_amdgcn_global_load_lds((const unsigned*)(BV2 + (g * 4 + (w >> 1)) * 8192 + dist_), (LAS unsigned*)(lds + NS_T + (buf) * NS_TBUF + (w >> 1) * NS_TROW + (w & 1) * 256), 4, 0, 0); } while (0)
#define NS_WAIT_SYNC(more, ops) do { if (more) { if ((ops) == 5) asm volatile("s_waitcnt vmcnt(5)" ::: "memory"); else asm volatile("s_waitcnt vmcnt(4)" ::: "memory"); } \
                                     else asm volatile("s_waitcnt vmcnt(0)" ::: "memory"); __syncthreads(); } while (0)
#define NS_LANE_SETUP() \
    const int lane = lane_id_asm(); const int hi = lane >> 5, l31 = lane & 31, qi = l31 >> 2, r = l31 & 3, qoff = w * 8 + qi; \
    const unsigned kof0 = 256u * l31 + 16u * ((unsigned)hi ^ ((((unsigned)l31 & 3) << 2) | (((unsigned)l31 >> 2) & 3))); \
    const unsigned vof0 = 256u * (4 * hi + (((unsigned)lane & 15) >> 2)) + 8u * ((unsigned)lane & 1) + 64u * (((unsigned)lane & 15) >> 2) + 16u * ((2 * (((unsigned)lane >> 4) & 1) + (((unsigned)lane & 3) >> 1)) ^ (unsigned)hi); \
    LAS float* improw = (LAS float*)(lds + NS_IMP) + (w * 8 + qi) * NS_IMPROW; (void)improw; \
    bf16* orow = ONSA + (size_t)(m0 + qoff) * 1024 + (g * 4 + r) * 128; (void)orow; (void)kof0; (void)vof0; \
    const unsigned okvA = NS_OFF(0u, (unsigned)KVW), okvB = NS_OFF(1u, (unsigned)KVW); (void)okvA; (void)okvB;
    for (int c = blockIdx.x; c < 256; c += F.G) {
#pragma unroll 1
        for (int u4 = 0; u4 < 4; ++u4) {
            const int xq = c & 7, iq = c >> 3, b = xq >> 1, g = xq & 1, jt = u4 == 0 ? iq : (u4 == 1 ? 63 - iq : (u4 == 2 ? 64 + iq : 127 - iq)), t0 = jt * 64, m0 = b * T + t0;
            bf16x8v Qf[8];
#pragma unroll
            for (int ks = 0; ks < 8; ++ks) Qf[ks] = *(const bf16x8v*)(QN + (size_t)(m0 + qoff) * 1024 + (g * 4 + r) * 128 + 16 * ks + 8 * hi);
            LAS float* gl = (LAS float*)(lds + NS_GATE) + (w * 32 + l31) * 4;
            if (hi == 0) { const float* gp0 = GATES + (size_t)(m0 + qoff) * 24 + (g * 4 + r) * 3; const float ga = gp0[0], gb = gp0[1], gc = gp0[2]; gl[0] = ga; gl[1] = gb; gl[2] = gc; }
#define gate0 (((const LAS float*)(lds + NS_GATE) + (w * 32 + (lane & 31)) * 4)[0])
#define gate1 (((const LAS float*)(lds + NS_GATE) + (w * 32 + (lane & 31)) * 4)[1])
#define gate2 (((const LAS float*)(lds + NS_GATE) + (w * 32 + (lane & 31)) * 4)[2])
            bf16* orow = ONSA + (size_t)(m0 + qoff) * 1024 + (g * 4 + r) * 128;
            f32x16 O[4]; float m_run, l_run;
            const int ntl = (((t0 + 32) >> 4) >> 6) + 1;
            const bf16* kcb = KC + ((size_t)(b * 512) * 2 + g) * 128; const bf16* vcb = VC + ((size_t)(b * 512) * 2 + g) * 128;
            for (int i = lane; i < 8 * NS_IMPROW; i += 64) ((LAS float*)(lds + NS_IMP))[w * 8 * NS_IMPROW + i] = 0.f;
            float m_fin = 0.f, inv_l = 0.f;
#ifndef NS_SKIP_CMP
            { NS_LANE_SETUP();
            const int tq = t0 + qoff; const int nlim = tq >= 31 ? ((tq - 31) >> 4) : -1;
            {
                m_run = 0.f; l_run = 0.f;
                NS_DMA_KV(kcb, vcb, oc0, oc1, 0);
                if (ntl > 1) NS_DMA_KV(kcb + (size_t)64 * 256, vcb + (size_t)64 * 256, oc0, oc1, 1);
#pragma unroll 1
                for (int tl = 0; tl < ntl; ++tl) {
                    NS_WAIT_SYNC(tl + 1 < ntl, 4);
                    if (tl + 2 < ntl) NS_DMA_KV(kcb + (size_t)(tl + 2) * 64 * 256, vcb + (size_t)(tl + 2) * 64 * 256, oc0, oc1, (tl + 2) % 3);
                    ns_tile<0>(lds, NS_K + (tl % 3) * 16384, NS_V + (tl % 3) * 16384, 0u, false, Qf, kof0, vof0, true, -64, nlim - 64 * tl - 4 * hi, m_run, l_run, O, 0.f, improw, 0, r);
                }
                m_fin = m_run; inv_l = 1.0f / fmaxf(swap32_sum(l_run), 1e-30f);
                __syncthreads();
            }
            {
#pragma unroll
                for (int ct = 0; ct < 4; ++ct)
#pragma unroll
                    for (int i = 0; i < 16; ++i) O[ct][i] = 0.f;
                NS_DMA_KV(kcb, vcb, oc0, oc1, 0);
                if (ntl > 1) NS_DMA_KV(kcb + (size_t)64 * 256, vcb + (size_t)64 * 256, oc0, oc1, 1);
#pragma unroll 1
                for (int tl = 0; tl < ntl; ++tl) {
                    NS_WAIT_SYNC(tl + 1 < ntl, 4);
                    if (tl + 2 < ntl) NS_DMA_KV(kcb + (size_t)(tl + 2) * 64 * 256, vcb + (size_t)(tl + 2) * 64 * 256, oc0, oc1, (tl + 2) % 3);
                    m_run = m_fin;
                    ns_tile<1>(lds, NS_K + (tl % 3) * 16384, NS_V + (tl % 3) * 16384, 0u, false, Qf, kof0, vof0, true, -64, nlim - 64 * tl - 4 * hi, m_run, l_run, O, inv_l, improw, 16 * tl + hi, r);
                }
            }
            ns_emit_rows(lds, w, ntl % 3, (ntl + 1) % 3, ONSA + (size_t)(m0 + w * 8) * 1024 + g * 512, O, gate0, lane, false);
            }
#endif
            unsigned wv0 = 0u, wv1 = 0u, wv2 = 0u, wv3 = 0u;
            const int lane = lane_id_asm();
            LAS unsigned* qsel = (LAS unsigned*)(lds + NS_WM + 128) + w * 32;
            {
                unsigned kk[8][2], tau[8];
#pragma unroll
                for (int qq = 0; qq < 8; ++qq) { const int tqq = t0 + w * 8 + qq; const LAS float* ir = (const LAS float*)(lds + NS_IMP) + (w * 8 + qq) * NS_IMPROW; tau[qq] = 0u;
#pragma unroll
                    for (int hh = 0; hh < 2; ++hh) { const int j = lane + 64 * hh; float v = ir[j];
                        if (j == 0 || j == jt || j == jt - 1) v = 1e9f;
                        if (j * 64 > tqq) v = NEGF;
                        kk[qq][hh] = (f2key(v) & 0xFFFFFF80u) | (unsigned)(127 - j); } }
#pragma unroll 1
                for (int bit = 31; bit >= 0; --bit) {
#pragma unroll
                    for (int qq = 0; qq < 8; ++qq) { const unsigned cand = tau[qq] | (1u << bit);
                        const int cnt = __popcll(__ballot(kk[qq][0] >= cand)) + __popcll(__ballot(kk[qq][1] >= cand)); if (cnt >= 16) tau[qq] = cand; }
                }
#pragma unroll
                for (int qq = 0; qq < 8; ++qq) {
                    const unsigned long long mlo = __ballot(kk[qq][0] >= tau[qq]), mhi = __ballot(kk[qq][1] >= tau[qq]);
                    const unsigned a0 = (unsigned)mlo, a1 = (unsigned)(mlo >> 32), a2 = (unsigned)mhi, a3 = (unsigned)(mhi >> 32);
                    if (lane == 0) { qsel[qq * 4 + 0] = a0; qsel[qq * 4 + 1] = a1; qsel[qq * 4 + 2] = a2; qsel[qq * 4 + 3] = a3; }
                    wv0 |= a0; wv1 |= a1; wv2 |= a2; wv3 |= a3;
                }
            }
            {
                const int nb = jt + 1;
                const unsigned f0 = nb >= 32 ? 0xFFFFFFFFu : ((1u << nb) - 1u), f1 = nb >= 64 ? 0xFFFFFFFFu : (nb > 32 ? ((1u << (nb - 32)) - 1u) : 0u);
                const unsigned f2 = nb >= 96 ? 0xFFFFFFFFu : (nb > 64 ? ((1u << (nb - 64)) - 1u) : 0u), f3 = nb >= 128 ? 0xFFFFFFFFu : (nb > 96 ? ((1u << (nb - 96)) - 1u) : 0u);
                wv0 &= f0; wv1 &= f1; wv2 &= f2; wv3 &= f3;
            }
            if (lane == 0) { LAS unsigned* wm = (LAS unsigned*)(lds + NS_WM) + w * 4; wm[0] = wv0; wm[1] = wv1; wm[2] = wv2; wm[3] = wv3; }
            __syncthreads();
            unsigned wg0 = 0u, wg1 = 0u, wg2 = 0u, wg3 = 0u;
#pragma unroll
            for (int ww = 0; ww < 8; ++ww) { const LAS unsigned* wm = (const LAS unsigned*)(lds + NS_WM) + ww * 4; wg0 |= wm[0]; wg1 |= wm[1]; wg2 |= wm[2]; wg3 |= wm[3]; }
            wg0 = __builtin_amdgcn_readfirstlane(wg0); wg1 = __builtin_amdgcn_readfirstlane(wg1); wg2 = __builtin_amdgcn_readfirstlane(wg2); wg3 = __builtin_amdgcn_readfirstlane(wg3);
#ifndef NS_SKIP_SLC
#ifndef NS_SLC_REPS
#define NS_SLC_REPS 1
#endif
            for (int rep_s = 0; rep_s < NS_SLC_REPS; ++rep_s) { NS_LANE_SETUP();
                m_run = 0.f; l_run = 0.f;
#pragma unroll
                for (int ct = 0; ct < 4; ++ct)
#pragma unroll
                    for (int i = 0; i < 16; ++i) O[ct][i] = 0.f;
                const bf16* ksb = KV + (size_t)(b * T) * KVW + 2 * 256 + g * 128; const bf16* vsb = ksb + 256;
                int j = ns_next_bit(wg0, wg1, wg2, wg3, 0);
                int jn = ns_next_bit(wg0, wg1, wg2, wg3, j + 1);
                NS_DMA_KV(ksb + (size_t)j * 64 * KVW, vsb + (size_t)j * 64 * KVW, okvA, okvB, 0); NS_DMA_T(j, 0);
                if (jn < 128) { NS_DMA_KV(ksb + (size_t)jn * 64 * KVW, vsb + (size_t)jn * 64 * KVW, okvA, okvB, 1); NS_DMA_T(jn, 1); }
                int it = 0;
#pragma unroll 1
                while (j < 128) {
                    NS_WAIT_SYNC(jn < 128, 5);
                    const int jnn = jn < 128 ? ns_next_bit(wg0, wg1, wg2, wg3, jn + 1) : 128;
                    const int b3 = it % 3, b3n = (it + 2) % 3;
                    if (jnn < 128) { NS_DMA_KV(ksb + (size_t)jnn * 64 * KVW, vsb + (size_t)jnn * 64 * KVW, okvA, okvB, b3n); NS_DMA_T(jnn, b3n); }
                    const unsigned wsel = j < 32 ? wv0 : (j < 64 ? wv1 : (j < 96 ? wv2 : wv3));
#ifdef NS_SLC_DRY
                    if (rep_s == NS_SLC_REPS - 1)
#endif
                    if ((wsel >> (j & 31)) & 1u) {
                        const unsigned lselw = qsel[qi * 4 + (j >> 5)];
                        const bool lsel = (lselw >> (j & 31)) & 1u;
                        const bool constb = (j < jt) && (rel_bucket(64 * (jt - j) - 63) == rel_bucket(64 * (jt - j) + 63));
                        const unsigned trow = (unsigned)(NS_T + b3 * NS_TBUF + r * NS_TROW);
                        const float cbv = constb ? *(const LAS float*)(lds + trow + 63 * 4) : 0.f;
                        ns_tile<2>(lds, NS_K + b3 * 16384, NS_V + b3 * 16384, trow + (unsigned)((63 - qoff + 4 * hi) * 4), constb, Qf, kof0, vof0, j == jt, -64, qoff - 4 * hi, m_run, l_run, O, 0.f, improw, 0, r, cbv, !lsel);
                    }
                    j = jn; jn = jnn; ++it;
                }
                __syncthreads();
                if (rep_s == NS_SLC_REPS - 1) ns_emit_rows(lds, w, 0, 1, ONSA + (size_t)(m0 + w * 8) * 1024 + g * 512, O, gate1 / fmaxf(swap32_sum(l_run), 1e-30f), lane, true);
            }
#endif
#ifndef NS_SKIP_WIN
            { NS_LANE_SETUP();
                m_run = 0.f; l_run = 0.f;
#pragma unroll
                for (int ct = 0; ct < 4; ++ct)
#pragma unroll
                    for (int i = 0; i < 16; ++i) O[ct][i] = 0.f;
                const bf16* kwb = KV + (size_t)(b * T) * KVW + 4 * 256 + g * 128; const bf16* vwb = kwb + 256;
                const int j0 = jt >= 8 ? jt - 8 : 0;
                NS_DMA_KV(kwb + (size_t)j0 * 64 * KVW, vwb + (size_t)j0 * 64 * KVW, okvA, okvB, 0); NS_DMA_T(j0, 0);
                if (j0 < jt) { NS_DMA_KV(kwb + (size_t)(j0 + 1) * 64 * KVW, vwb + (size_t)(j0 + 1) * 64 * KVW, okvA, okvB, 1); NS_DMA_T(j0 + 1, 1); }
#pragma unroll 1
                for (int j = j0; j <= jt; ++j) {
                    const int it = j - j0, b3 = it % 3, b3n = (it + 2) % 3;
                    NS_WAIT_SYNC(j < jt, 5);
                    if (j + 2 <= jt) { NS_DMA_KV(kwb + (size_t)(j + 2) * 64 * KVW, vwb + (size_t)(j + 2) * 64 * KVW, okvA, okvB, b3n); NS_DMA_T(j + 2, b3n); }
                    const unsigned tbase = (unsigned)(NS_T + b3 * NS_TBUF + r * NS_TROW + (63 - qoff + 4 * hi) * 4);
                    const bool first = (j == jt - 8), diag = (j == jt);
                    ns_tile<2>(lds, NS_K + b3 * 16384, NS_V + b3 * 16384, tbase, false, Qf, kof0, vof0, first || diag, first ? qoff + 1 - 4 * hi : -64, diag ? qoff - 4 * hi : 1000, m_run, l_run, O, 0.f, improw, 0, r);
                }
                __syncthreads();
                ns_emit_rows(lds, w, 0, 1, ONSA + (size_t)(m0 + w * 8) * 1024 + g * 512, O, gate2 / fmaxf(swap32_sum(l_run), 1e-30f), lane, true);
            }
#endif
        }
    }
#undef NS_DMA_KV
#undef NS_DMA_T
#undef NS_WAIT_SYNC
#undef NS_OFF
#undef NS_LANE_SETUP
#undef gate0
#undef gate1
#undef gate2
#undef okv0
#undef okv1
#undef oc0
#undef oc1
}


constexpr int DA_WSTRIDE = 17664, DA_SEL = 16384, DA_BK = 17408, DA_RB = 8 * DA_WSTRIDE;
__device__ __forceinline__ void ph_dsa_attn_mfma(const Frame& F, const Params& P) {
    unsigned char* ws = P.ws;
    const bf16* QABS = (const bf16*)(ws + WS_QABS); const bf16* CKV = (const bf16*)(ws + WS_CKV); const unsigned short* SEL = (const unsigned short*)(ws + WS_SEL);
    bf16* OLAT = (bf16*)(ws + WS_XN);
    LAS unsigned char* lds = F.lds;
    const int lane = F.lane, w = F.wave, h16 = lane & 15, g4 = lane >> 4;
    LAS unsigned char* wl = lds + w * DA_WSTRIDE;
    for (int i = F.tid; i < 264; i += NTHR) ((LAS float*)(lds + DA_RB))[i] = i < 256 ? P.in[5][i] * 1.4426950408889634f : NEGF;
    __syncthreads();
    const LAS float* rb2 = (const LAS float*)(lds + DA_RB) + (h16 & 7);
    const unsigned kr0 = 256u * h16 + 16u * (((unsigned)g4) ^ ((((unsigned)h16 & 3) << 2) | (((unsigned)h16 >> 2) & 3)));
    const unsigned q_ = ((unsigned)h16) >> 2, p_ = (unsigned)h16 & 3;
    const unsigned vt0 = 256u * (4 * g4 + q_) + 8u * (p_ & 1) + 16u * (((p_ >> 1)) ^ ((q_ << 2) | (unsigned)g4));
    const unsigned dpos = (unsigned)h16, drl = (unsigned)g4;
    const int nq = M / F.NGW;
    const int xq_ = blockIdx.x & 7, wib = (((blockIdx.x >> 3) * 2 + (xq_ & 1)) * NWAVES + w), nwb = (F.G >> 2) * NWAVES;
#define DA_Q(qn_) (((xq_ >> 1) << 13) + (qn_) * nwb + wib)
#define DA_DMA(bq, sb, ch, kb) do { \
        _Pragma("unroll") for (int ii = 0; ii < 8; ++ii) { \
            const unsigned sv_ = *(const LAS unsigned short*)(wl + DA_SEL + (sb) * 512 + (32 * (ch) + 4 * ii + (int)drl) * 2); \
            const unsigned row_ = sv_ == 0xFFFFu ? 0u : sv_; \
            const bf16* src_ = CKV + ((size_t)(bq) * T + row_) * 128 + ((dpos ^ ((drl << 2) | (unsigned)(ii & 3))) * 8); \
            __builtin_amdgcn_global_load_lds((const unsigned*)src_, (LAS unsigned*)(wl + (kb) * 8192 + ii * 1024), 16, 0, 0); } } while (0)
    {
        const int m = DA_Q(0);
        const v2u sv = *((const v2u*)(SEL + (size_t)m * 256) + lane);
        *((LAS v2u*)(wl + DA_SEL) + lane) = sv;
        LDS_WAIT(); asm volatile("" ::: "memory");
        DA_DMA(m >> 13, 0, 0, 0);
    }
#pragma unroll 1
    for (int qn = 0; qn < nq; ++qn) {
        const int m = DA_Q(qn), mnext = DA_Q(qn + 1), b = m >> 13, t = m & 8191, sb = qn & 1;
        v2u svn; svn.x = 0u; svn.y = 0u;
        if (qn + 1 < nq) svn = *((const v2u*)(SEL + (size_t)mnext * 256) + lane);
        bf16x8v Qf[4];
#pragma unroll
        for (int ks = 0; ks < 4; ++ks) { v4u z; z.x = 0u; z.y = 0u; z.z = 0u; z.w = 0u;
            if (h16 < 8) z = *(const v4u*)(QABS + (size_t)m * 1024 + h16 * 128 + 32 * ks + 8 * g4);
            Qf[ks] = __builtin_bit_cast(bf16x8v, z); }
        f32x4 O[8]; float m_run = 0.f, l_run = 0.f;
#pragma unroll
        for (int ct = 0; ct < 8; ++ct) O[ct] = (f32x4){0.f, 0.f, 0.f, 0.f};
        {
            const v2u s4 = *((const LAS v2u*)(wl + DA_SEL + sb * 512) + lane);
            const unsigned sv4[4] = {s4.x & 0xffffu, s4.x >> 16, s4.y & 0xffffu, s4.y >> 16};
            unsigned pk = 0u;
#pragma unroll
            for (int i = 0; i < 4; ++i) { const unsigned bk_ = sv4[i] == 0xFFFFu ? 32u : (unsigned)rel_bucket(t - (int)sv4[i]); pk |= bk_ << (8 * i); }
            *((LAS unsigned*)(wl + DA_BK) + lane) = pk;
            LDS_WAIT(); asm volatile("" ::: "memory");
        }
#pragma unroll 1
        for (int ch = 0; ch < 8; ++ch) {
            const int it = qn * 8 + ch, kb = it & 1;
            if (ch < 7) { DA_DMA(b, sb, ch + 1, kb ^ 1); asm volatile("s_waitcnt vmcnt(8)" ::: "memory"); }
            else if (qn + 1 < nq) { *((LAS v2u*)(wl + DA_SEL + (sb ^ 1) * 512) + lane) = svn; LDS_WAIT(); asm volatile("" ::: "memory");
                                    DA_DMA(mnext >> 13, sb ^ 1, 0, kb ^ 1); asm volatile("s_waitcnt vmcnt(8)" ::: "memory"); }
            else asm volatile("s_waitcnt vmcnt(0)" ::: "memory");
            const LAS unsigned char* kbuf = wl + kb * 8192;
            f32x4 D0, D1;
            { const unsigned b0 = *((const LAS unsigned*)(wl + DA_BK) + 8 * ch + g4), b1 = *((const LAS unsigned*)(wl + DA_BK) + 8 * ch + 4 + g4);
#pragma unroll
              for (int i = 0; i < 4; ++i) { D0[i] = rb2[((b0 >> (8 * i)) & 0xffu) * 8]; D1[i] = rb2[((b1 >> (8 * i)) & 0xffu) * 8]; } }
            {
                const unsigned kb_ = (unsigned)(uintptr_t)kbuf; const unsigned a0_ = kb_ + kr0, a1_ = kb_ + (kr0 ^ 64u), a2_ = kb_ + (kr0 ^ 128u), a3_ = kb_ + (kr0 ^ 192u);
                bf16x8v f0, f1, f2, f3, f4, f5, f6, f7;
                asm volatile("ds_read_b128 %0, %8\n\tds_read_b128 %1, %8 offset:4096\n\tds_read_b128 %2, %9\n\tds_read_b128 %3, %9 offset:4096\n\t"
                             "ds_read_b128 %4, %10\n\tds_read_b128 %5, %10 offset:4096\n\tds_read_b128 %6, %11\n\tds_read_b128 %7, %11 offset:4096\n\ts_waitcnt lgkmcnt(0)"
                             : "=&v"(f0), "=&v"(f1), "=&v"(f2), "=&v"(f3), "=&v"(f4), "=&v"(f5), "=&v"(f6), "=&v"(f7) : "v"(a0_), "v"(a1_), "v"(a2_), "v"(a3_) : "memory");
                D0 = __builtin_amdgcn_mfma_f32_16x16x32_bf16(f0, Qf[0], D0, 0, 0, 0); D1 = __builtin_amdgcn_mfma_f32_16x16x32_bf16(f1, Qf[0], D1, 0, 0, 0);
                D0 = __builtin_amdgcn_mfma_f32_16x16x32_bf16(f2, Qf[1], D0, 0, 0, 0); D1 = __builtin_amdgcn_mfma_f32_16x16x32_bf16(f3, Qf[1], D1, 0, 0, 0);
                D0 = __builtin_amdgcn_mfma_f32_16x16x32_bf16(f4, Qf[2], D0, 0, 0, 0); D1 = __builtin_amdgcn_mfma_f32_16x16x32_bf16(f5, Qf[2], D1, 0, 0, 0);
                D0 = __builtin_amdgcn_mfma_f32_16x16x32_bf16(f6, Qf[3], D0, 0, 0, 0); D1 = __builtin_amdgcn_mfma_f32_16x16x32_bf16(f7, Qf[3], D1, 0, 0, 0);
            }
            { const float mx = fmaxf(fmaxf(fmaxf(D0[0], D0[1]), fmaxf(D0[2], D0[3])), fmaxf(fmaxf(D1[0], D1[1]), fmaxf(D1[2], D1[3])));
              if (__ballot(mx > m_run + 60.f) != 0ull) {
                float mxx = fmaxf(mx, __shfl_xor(mx, 16)); mxx = fmaxf(mxx, __shfl_xor(mxx, 32));
                const float m_new = fmaxf(m_run, mxx);
                const float sc = __builtin_amdgcn_exp2f(m_run - m_new); l_run *= sc;
#pragma unroll
                for (int ct = 0; ct < 8; ++ct) O[ct] *= sc;
                m_run = m_new;
              } }
            float pv[8];
#pragma unroll
            for (int i = 0; i < 4; ++i) { pv[i] = __builtin_amdgcn_exp2f(D0[i] - m_run); pv[4 + i] = __builtin_amdgcn_exp2f(D1[i] - m_run); }
            l_run += ((pv[0] + pv[1]) + (pv[2] + pv[3])) + ((pv[4] + pv[5]) + (pv[6] + pv[7]));
            v4u pw; pw.x = cvtpk(pv[0], pv[1]); pw.y = cvtpk(pv[2], pv[3]); pw.z = cvtpk(pv[4], pv[5]); pw.w = cvtpk(pv[6], pv[7]);
            const bf16x8v pf = __builtin_bit_cast(bf16x8v, pw);
            {
                const unsigned vb_ = (unsigned)(uintptr_t)kbuf;
                v2u lo[8], hi_[8];
#define DA_TR4(c0) asm volatile("ds_read_b64_tr_b16 %0, %8\n\tds_read_b64_tr_b16 %1, %8 offset:4096\n\tds_read_b64_tr_b16 %2, %9\n\tds_read_b64_tr_b16 %3, %9 offset:4096\n\t" \
                             "ds_read_b64_tr_b16 %4, %10\n\tds_read_b64_tr_b16 %5, %10 offset:4096\n\tds_read_b64_tr_b16 %6, %11\n\tds_read_b64_tr_b16 %7, %11 offset:4096" \
                             : "=&v"(lo[c0]), "=&v"(hi_[c0]), "=&v"(lo[c0 + 1]), "=&v"(hi_[c0 + 1]), "=&v"(lo[c0 + 2]), "=&v"(hi_[c0 + 2]), "=&v"(lo[c0 + 3]), "=&v"(hi_[c0 + 3]) \
                             : "v"(vb_ + (vt0 ^ (32u * (c0)))), "v"(vb_ + (vt0 ^ (32u * (c0 + 1)))), "v"(vb_ + (vt0 ^ (32u * (c0 + 2)))), "v"(vb_ + (vt0 ^ (32u * (c0 + 3)))) : "memory")
                DA_TR4(0); DA_TR4(4);
                asm volatile("s_waitcnt lgkmcnt(8)" : "+v"(lo[0]), "+v"(hi_[0]), "+v"(lo[1]), "+v"(hi_[1]), "+v"(lo[2]), "+v"(hi_[2]), "+v"(lo[3]), "+v"(hi_[3]) :: "memory");
#pragma unroll
                for (int ct = 0; ct < 4; ++ct) O[ct] = __builtin_amdgcn_mfma_f32_16x16x32_bf16(vcat(lo[ct], hi_[ct]), pf, O[ct], 0, 0, 0);
                asm volatile("s_waitcnt lgkmcnt(0)" : "+v"(lo[4]), "+v"(hi_[4]), "+v"(lo[5]), "+v"(hi_[5]), "+v"(lo[6]), "+v"(hi_[6]), "+v"(lo[7]), "+v"(hi_[7]) :: "memory");
#pragma unroll
                for (int ct = 4; ct < 8; ++ct) O[ct] = __builtin_amdgcn_mfma_f32_16x16x32_bf16(vcat(lo[ct], hi_[ct]), pf, O[ct], 0, 0, 0);
#undef DA_TR4
            }
        }
        float lt = l_run; lt += __shfl_xor(lt, 16); lt += __shfl_xor(lt, 32);
        const float inv = 1.0f / fmaxf(lt, 1e-30f);
        if (h16 < 8) { bf16* orow = OLAT + (size_t)m * 1024 + h16 * 128 + 4 * g4;
#pragma unroll
            for (int ct = 0; ct < 8; ++ct) { v2u o; o.x = cvtpk(O[ct][0] * inv, O[ct][1] * inv); o.y = cvtpk(O[ct][2] * inv, O[ct][3] * inv); *(v2u*)(orow + 16 * ct) = o; } }
    }
#undef DA_DMA
#undef DA_Q
}

typedef GAS unsigned gu32;
#define RLX_AGENT __ATOMIC_RELAXED, __HIP_MEMORY_SCOPE_AGENT
#define XB_TMO      128
#define XB_XCNT(j)  (256  + 64 * (j))
#define XB_XSUB(j)  (1280 + 64 * (j))
#define XB_XGEN(j)  (2304 + 64 * (j))
#define XB_TOP      3328
#define XB_TOPGEN   3392
#define XCD_BAR_WORDS 3456
#define XB_SPIN_CAP (1u << 18)

__device__ __forceinline__ unsigned xb_ld(unsigned* p)              { return __hip_atomic_load(p, __ATOMIC_RELAXED, __HIP_MEMORY_SCOPE_AGENT); }
__device__ __forceinline__ unsigned xb_add(unsigned* p, unsigned v) { return __hip_atomic_fetch_add(p, v, __ATOMIC_RELAXED, __HIP_MEMORY_SCOPE_AGENT); }
__device__ __forceinline__ unsigned xb_xcc_id() { return (unsigned)__builtin_amdgcn_s_getreg((3 << 11) | 20) & 0xFu; }
#define XB_SPIN(cond, bar) do { unsigned _sp = 0; while (cond) { __builtin_amdgcn_s_sleep(1); \
    if ((++_sp & 255u) == 0u) { if (xb_ld(&(bar)[XB_TMO])) break; if (_sp > XB_SPIN_CAP) { atomicAdd(&(bar)[XB_TMO], 1u); break; } } } } while (0)

struct XcdBarrier {
    unsigned* bar; unsigned x;
    volatile LAS unsigned* st;
};

__device__ __forceinline__ XcdBarrier xcd_barrier_post(unsigned* bar, volatile LAS unsigned* st) {
    XcdBarrier b; b.bar = bar; b.x = xb_xcc_id(); b.st = st;
    if (threadIdx.x == 0) (void)xb_add(&bar[XB_XCNT(b.x)], 1u);
    return b;
}
__device__ __forceinline__ void xcd_barrier_complete(unsigned* bar, unsigned x, unsigned& nloc, unsigned& nx) {
    const unsigned G = gridDim.x * gridDim.y * gridDim.z;
    unsigned sum, cnt, mine, sp = 0u;
    for (;;) {
        sum = 0u; cnt = 0u; mine = 0u;
#pragma unroll
        for (unsigned j = 0; j < 16; ++j) { const unsigned c = xb_ld(&bar[XB_XCNT(j)]); sum += c; cnt += (c > 0u) ? 1u : 0u; mine = (j == x) ? c : mine; }
        if (sum == G) break;
        __builtin_amdgcn_s_sleep(1);
        if ((++sp & 255u) == 0u) { if (xb_ld(&bar[XB_TMO])) break; if (sp > XB_SPIN_CAP) { atomicAdd(&bar[XB_TMO], 1u); break; } }
    }
    nloc = mine > 0u ? mine : 1u; nx = cnt > 0u ? cnt : 1u;
}

__device__ __forceinline__ void xcd_barrier(const XcdBarrier& b, const int wave_sgpr) {
    asm volatile("s_waitcnt vmcnt(0)" ::: "memory");
    __syncthreads();
    if (wave_sgpr == 0 && lane_id_asm() == 0) {
        unsigned* bar = b.bar;
        __builtin_amdgcn_s_waitcnt(0);
        unsigned nloc = b.st[0], nx = b.st[1];
        if (nloc == 0u) { xcd_barrier_complete(bar, b.x, nloc, nx); b.st[0] = nloc; b.st[1] = nx; }
        const unsigned old = xb_add(&bar[XB_XSUB(b.x)], 1u);
        const unsigned gen = old / nloc;
        if (old + 1u == (gen + 1u) * nloc) {
            __builtin_amdgcn_fence(__ATOMIC_RELEASE, "agent");
            asm volatile("s_waitcnt vmcnt(0)" ::: "memory");
            const unsigned og = xb_add(&bar[XB_TOP], 1u);
            const unsigned tg = og / nx;
            if (og + 1u == (tg + 1u) * nx) xb_add(&bar[XB_TOPGEN], 1u);
            else XB_SPIN(xb_ld(&bar[XB_TOPGEN]) == tg, bar);
            __builtin_amdgcn_fence(__ATOMIC_ACQUIRE, "agent");
            xb_add(&bar[XB_XGEN(b.x)], 1u);
            asm volatile("s_waitcnt vmcnt(0)" ::: "memory");
        } else {
            XB_SPIN(xb_ld(&bar[XB_XGEN(b.x)]) == gen, bar);
            __builtin_amdgcn_fence(__ATOMIC_ACQUIRE, "agent");
            asm volatile("s_waitcnt vmcnt(0)" ::: "memory");
        }
    }
    __syncthreads();
}

enum Phase { PH_PROLOGUE = 0, PH_G1, PH_PREP, PH_G2, PH_INDEX, PH_DSA_ATTN, PH_G3, PH_NORM1, PH_UP0, PH_DN0, PH_NORM2, PH_G6, PH_CMP_GATHER, PH_CMP_GEMM, PH_CMP_REDUCE,
             PH_NSA_ATTN, PH_G7, PH_NORM3, PH_UP1, PH_DN1, PH_FINAL, PH_COUNT };

__global__ void __launch_bounds__(NTHR, 2) mk_fwd(Params P) {
    extern __shared__ __attribute__((aligned(16))) unsigned char lds[];
    cg::grid_group grid = cg::this_grid();
    Frame F;
    F.lds = (LAS unsigned char*)lds;
    F.tid = threadIdx.x; F.lane = F.tid & 63; F.wave = __builtin_amdgcn_readfirstlane(F.tid >> 6);
    F.G = gridDim.x; F.gw = blockIdx.x * NWAVES + F.wave; F.NGW = F.G * NWAVES;
    unsigned char* ws = P.ws;
    const int lo = P.ph_lo, hi = P.ph_hi; (void)lo; (void)hi;
    volatile LAS unsigned* MISC = (volatile LAS unsigned*)(F.lds + LDS_BYTES - 64);
    if (F.tid < 16) MISC[F.tid] = 0u;
    __syncthreads();
    XcdBarrier bar = xcd_barrier_post((unsigned*)ws, MISC + 8);
    pg8::bf16_t* XN = (pg8::bf16_t*)(ws + WS_XN);
#ifndef MK_PH_MASK
#define MK_PH_MASK 0xFFFFFFFFu
#endif
#ifdef MK_CUTS
#define IN(k) (((MK_PH_MASK >> (k)) & 1u) && lo <= (k) && (k) < hi)
#else
#define IN(k) ((MK_PH_MASK >> (k)) & 1u)
#endif
#ifndef MK_REPEAT
#define MK_REPEAT -1
#endif
#define RP(k) for (int rep_ = 0; rep_ < ((MK_REPEAT == (k)) ? 2 : 1); ++rep_)
#define REFRAME() do { F.lane = lane_id_asm(); F.tid = F.wave * 64 + F.lane; } while (0)
#define SEAM(k) do { if (IN(k) && IN((k) + 1)) xcd_barrier(bar, F.wave); } while (0)
#define SEAM_CG(k) do { if (IN(k) && IN((k) + 1)) grid.sync(); } while (0)
#define GEMM_PHASE_RC(EpiT, gemm, epi) do { typedef pg8::ChunkOrder<M / 256, FF / 1024> CO_; CO_ S_{F.G, (int)blockIdx.x}; \
        pg8::stage_rstd((PG8_LAS unsigned char*)F.lds, (const float*)(ws + WS_SSQ), S_, F.wave * 64 + lane_id_asm()); \
        pg8::gemm_phase<EpiT, CO_, true, true, false>((PG8_LAS unsigned char*)F.lds, (gemm), S_, (epi), F.wave); } while (0)
#define GEMM_PHASE_R(EpiT, gemm, epi) do { pg8::StaticOrder S_; S_.init((gemm).M, (gemm).N, F.G, (int)blockIdx.x); \
        pg8::stage_rstd((PG8_LAS unsigned char*)F.lds, (const float*)(ws + WS_SSQ), S_, F.wave * 64 + lane_id_asm()); \
        pg8::gemm_phase<EpiT, pg8::StaticOrder, true, true, false>((PG8_LAS unsigned char*)F.lds, (gemm), S_, (epi), F.wave); } while (0)
#define GEMM_PHASE(EpiT, gemm, epi, F16_) do { pg8::StaticOrder S_; S_.init((gemm).M, (gemm).N, F.G, (int)blockIdx.x); \
        pg8::gemm_phase<EpiT, pg8::StaticOrder, true, true, F16_>((PG8_LAS unsigned char*)F.lds, (gemm), S_, (epi), F.wave); } while (0)

    if (IN(PH_PROLOGUE)) RP(PH_PROLOGUE) { REFRAME(); ph_prologue(F, P); }
    SEAM_CG(PH_PROLOGUE);
    if (IN(PH_G1)) RP(PH_G1) {
        pg8::Gemm g{XN, (const pg8::bf16_t*)(ws + WS_W_IN0), M, 512, D};
        pg8::EpiPrep E{(pg8::bf16_t*)(ws + WS_CQ), (pg8::bf16_t*)(ws + WS_CKV), (pg8::bf16_t*)(ws + WS_KIDX), (float*)(ws + WS_WIDX), P.in[8], P.in[9], WIDX_SCALE};
        GEMM_PHASE(pg8::EpiPrep, g, E, true);
    }
    SEAM(PH_G1);
    if (IN(PH_G2)) RP(PH_G2) {
        { pg8::Gemm g{(const pg8::bf16_t*)(ws + WS_CQ), (const pg8::bf16_t*)(ws + WS_W_Q2), M, 1024, 256}; pg8::EpiPk<false> E{(pg8::bf16_t*)(ws + WS_QABS), 1024};
          GEMM_PHASE(pg8::EpiPk<false>, g, E, true); }
        { pg8::Gemm g{(const pg8::bf16_t*)(ws + WS_CQ), (const pg8::bf16_t*)(ws + WS_W_Q2) + (size_t)1024 * 256, M, 512, 256}; pg8::EpiPk<true> E{(pg8::bf16_t*)(ws + WS_QIDX), 512};
          GEMM_PHASE(pg8::EpiPk<true>, g, E, true); }
    }
    SEAM(PH_G2);
    if (IN(PH_INDEX)) RP(PH_INDEX) { REFRAME(); ph_index_mfma(F, P); }
    SEAM(PH_INDEX);
    if (IN(PH_DSA_ATTN)) RP(PH_DSA_ATTN) { REFRAME(); ph_dsa_attn_mfma(F, P); }
    SEAM(PH_DSA_ATTN);
    if (IN(PH_G3)) {
        pg8::Gemm g{XN, (const pg8::bf16_t*)(ws + WS_W_UVO), M, D, D}; pg8::EpiResB<true> E{P.in[0], (pg8::bf16_t*)(ws + WS_RB), (float*)(ws + WS_SSQ), D};
        GEMM_PHASE(pg8::EpiResB<true>, g, E, false);
    }
    SEAM(PH_G3);
#define MLP_PHASES(l, base) \
    if (IN((base) + 1)) RP(PH_UP0) {     \
        pg8::Gemm g{(const pg8::bf16_t*)(ws + WS_RB), (const pg8::bf16_t*)(ws + WS_W_UP) + (size_t)(l) * FF * D, M, FF, D}; pg8::EpiRelu2 E{(pg8::bf16_t*)(ws + WS_U), FF, (PG8_LAS unsigned char*)F.lds}; \
        GEMM_PHASE_RC(pg8::EpiRelu2, g, E); \
    } \
    SEAM((base) + 1); \
    if (IN((base) + 2)) {     \
        pg8::Gemm g{(const pg8::bf16_t*)(ws + WS_U), (const pg8::bf16_t*)(ws + WS_W_DN) + (size_t)(l) * D * FF, M, D, FF}; pg8::EpiResB<false> E{nullptr, (pg8::bf16_t*)(ws + WS_RB), (float*)(ws + WS_SSQ), D}; \
        GEMM_PHASE(pg8::EpiResB<false>, g, E, false); \
    } \
    SEAM((base) + 2);
    MLP_PHASES(0, PH_NORM1)
    if (IN(PH_G6)) RP(PH_G6) {
        pg8::Gemm g{(const pg8::bf16_t*)(ws + WS_RB), (const pg8::bf16_t*)(ws + WS_W_KVQ), M, 2560, D}; pg8::EpiKVQ E{(pg8::bf16_t*)(ws + WS_KV), (pg8::bf16_t*)(ws + WS_QN), (PG8_LAS unsigned char*)F.lds, (pg8::bf16_t*)(ws + WS_FLAT), P.in[17], P.in[18]};
        GEMM_PHASE_R(pg8::EpiKVQ, g, E);
    }
    SEAM(PH_G6);
    if (IN(PH_CMP_GEMM)) RP(PH_CMP_GEMM) {
        pg8::Gemm g{(const pg8::bf16_t*)(ws + WS_FLAT), (const pg8::bf16_t*)(ws + WS_W_C1), 32768, 2048, 1024}; pg8::EpiPart E{(float*)(ws + WS_PART)};
        CmpOrder S_{F.G, (int)blockIdx.x};
        pg8::gemm_phase<pg8::EpiPart, CmpOrder, true, true>((PG8_LAS unsigned char*)F.lds, g, S_, E, F.wave);
        pg8::Gemm gg{(const pg8::bf16_t*)(ws + WS_RB), (const pg8::bf16_t*)(ws + WS_W_KVQ) + (size_t)2560 * D, M, 256, D}; pg8::EpiGate EG{(float*)(ws + WS_GATES), (PG8_LAS unsigned char*)F.lds};
        GateOrder SG_{F.G, (int)blockIdx.x};
        pg8::stage_rstd((PG8_LAS unsigned char*)F.lds, (const float*)(ws + WS_SSQ), SG_, F.wave * 64 + lane_id_asm());
        pg8::gemm_phase<pg8::EpiGate, GateOrder, true, true>((PG8_LAS unsigned char*)F.lds, gg, SG_, EG, F.wave);
    }
    SEAM(PH_CMP_GEMM);
    if (IN(PH_CMP_REDUCE)) RP(PH_CMP_REDUCE) { REFRAME(); ph_cmp_reduce(F, P); }
    SEAM(PH_CMP_REDUCE);
    if (IN(PH_NSA_ATTN)) RP(PH_NSA_ATTN) { REFRAME(); ph_nsa_attn_flash(F, P); }
    SEAM(PH_NSA_ATTN);
    if (IN(PH_G7)) {
        pg8::Gemm g{XN, (const pg8::bf16_t*)(ws + WS_W_O1), M, D, D}; pg8::EpiResB<false> E{nullptr, (pg8::bf16_t*)(ws + WS_RB), (float*)(ws + WS_SSQ), D};
        GEMM_PHASE(pg8::EpiResB<false>, g, E, false);
    }
    SEAM(PH_G7);
    MLP_PHASES(1, PH_NORM3)
#undef MLP_PHASES
    if (IN(PH_FINAL)) { REFRAME(); ph_final_norm(F, (const bf16*)(ws + WS_RB), (const float*)(ws + WS_SSQ), P.out, P.in[25]); }
#undef IN
#undef SEAM
#undef GEMM_PHASE
}

extern "C" void kernel_launch(void* const* d_in, const int* in_sizes, int n_in, void* d_out, int out_size, void* d_ws, size_t ws_size, hipStream_t stream) {
    static int grid = 0;
    if (grid == 0) {
        if (n_in != 26 || out_size != M * D || ws_size < WS_END) { fprintf(stderr, "kernel_launch: unexpected problem (n_in %d, out %d, ws %zu); nothing launched\n", n_in, out_size, ws_size); grid = -1; return; }
        int dev = 0, cus = 0, per_cu = 0;
        if (hipGetDevice(&dev) != hipSuccess || hipDeviceGetAttribute(&cus, hipDeviceAttributeMultiprocessorCount, dev) != hipSuccess) { grid = -1; return; }
        if (hipFuncSetAttribute((const void*)mk_fwd, hipFuncAttributeMaxDynamicSharedMemorySize, LDS_BYTES) != hipSuccess) { fprintf(stderr, "kernel_launch: hipFuncSetAttribute failed\n"); grid = -1; return; }
        if (hipOccupancyMaxActiveBlocksPerMultiprocessor(&per_cu, (const void*)mk_fwd, NTHR, LDS_BYTES) != hipSuccess || per_cu < 1) { fprintf(stderr, "kernel_launch: occupancy query says %d\n", per_cu); per_cu = 1; }
        (void)hipGetLastError();
        grid = cus * (per_cu > 1 ? 1 : per_cu);
        if (grid != 256) fprintf(stderr, "kernel_launch: note: %d workgroups\n", grid);
    }
    if (grid < 0) return;
    if (hipMemsetAsync(d_ws, 0, 16384, stream) != hipSuccess) { fprintf(stderr, "kernel_launch: memset failed\n"); return; }
    Params p{};
    for (int i = 0; i < 26; ++i) p.in[i] = (const float*)d_in[i];
    p.out = (float*)d_out; p.ws = (unsigned char*)d_ws;
#ifndef MK_CUTS
    p.ph_lo = 0; p.ph_hi = PH_COUNT;
    void* args[] = {&p};
    hipError_t e = hipLaunchCooperativeKernel((const void*)mk_fwd, dim3(grid), dim3(NTHR), args, LDS_BYTES, stream);
    if (e != hipSuccess) fprintf(stderr, "cooperative launch failed: %s (grid %d)\n", hipGetErrorString(e), grid);
#else
    for (int k = 0; k < PH_COUNT; ++k) {
        p.ph_lo = k; p.ph_hi = k + 1;
        void* args[] = {&p};
        hipError_t e = hipLaunchCooperativeKernel((const void*)mk_fwd, dim3(grid), dim3(NTHR), args, LDS_BYTES, stream);
        if (e != hipSuccess) { fprintf(stderr, "launch %d failed: %s\n", k, hipGetErrorString(e)); break; }
    }
#endif
}
```

```cpp
#include <hip/hip_runtime.h>
#include <hip/hip_cooperative_groups.h>
#include <cstdio>
#include <cstdint>
#include <type_traits>
namespace cg = cooperative_groups;
__device__ __forceinline__ int lane_id_asm() { int l; asm volatile("v_mbcnt_lo_u32_b32 %0, -1, 0\n\tv_mbcnt_hi_u32_b32 %0, -1, %0" : "=v"(l)); return l; }
namespace pg8 {
#define PG8_LAS __attribute__((address_space(3)))
typedef unsigned short bf16_t;
typedef short bf16x8 __attribute__((ext_vector_type(8)));
typedef float f32x4 __attribute__((ext_vector_type(4)));
typedef unsigned u32x4 __attribute__((ext_vector_type(4)));
constexpr int BM = 256, BK = 64, HALF = 128, HTB = HALF * BK * 2  , STAGE_BYTES = 8 * HTB, NXCD = 8, WGM = 4;

__host__ __device__ __forceinline__ int lds_byte(int r, int c) { const int st = (r >> 4) * 2 + (c >> 5), rr = r & 15, cc = c & 31, ob = rr * 64 + cc * 2; return st * 1024 + (ob ^ (((ob >> 9) & 1) << 5)); }
__host__ __device__ __forceinline__ void stage_rc(int b, int& R, int& C) { const int st = b / 1024, sb = b % 1024, swz = sb ^ (((sb >> 9) & 1) << 5); R = (st >> 1) * 16 + swz / 64; C = (st & 1) * 32 + (swz % 64) / 2; }
__host__ __device__ __forceinline__ int perm32(int rho) { const int n = rho >> 4, i = rho & 15; return 8 * (i >> 2) + 4 * n + (i & 3); }

struct Unit { int pm, pn, ui; };
struct Gemm { const bf16_t* A; const bf16_t* Bt; int M, N, K; };

struct StaticOrder {
    int nM, nN, nwg, G, c;
    __host__ __device__ void init(int M, int N, int G_, int c_) { nM = M / BM; nN = N / BM; nwg = nM * nN; G = G_; c = c_; }
    __host__ __device__ bool next(int i, Unit& u) const {
        const long L = (long)i * G + c; if (L >= nwg) return false;
        int wgid = (int)L; { const int q = nwg / NXCD, r = nwg % NXCD, xcd = wgid % NXCD, off = wgid / NXCD; wgid = (xcd < r ? xcd * (q + 1) : r * (q + 1) + (xcd - r) * q) + off; }
        const int nig = WGM * nN, gid = wgid / nig, fm = gid * WGM, gsz = (nM - fm) < WGM ? (nM - fm) : WGM;
        u.pm = fm + ((wgid % nig) % gsz); u.pn = (wgid % nig) / gsz; return true;
    }
    __device__ __forceinline__ void a_ready(const Unit&) const {}
    __device__ __forceinline__ void done(const Unit&) const {}
};

template <int NM, int NCH> struct ChunkOrder {
    int G, c;
    __host__ __device__ bool next(int i, Unit& u) const {
        constexpr int nwgc = NM * 4;
        if (c >= nwgc) return false;
        const int nv = (nwgc - c + G - 1) / G;
        int ch = 0, ii = i; while (ii >= nv) { ii -= nv; ++ch; }
        if (ch >= NCH) return false;
        int wgid = ii * G + c; { constexpr int q = nwgc / NXCD, r = nwgc % NXCD; const int xcd = wgid % NXCD, off = wgid / NXCD; wgid = (xcd < r ? xcd * (q + 1) : r * (q + 1) + (xcd - r) * q) + off; }
        constexpr int nig = WGM * 4; const int gid = wgid / nig, fm = gid * WGM, gsz = (NM - fm) < WGM ? (NM - fm) : WGM;
        u.pm = fm + ((wgid % nig) % gsz); u.pn = 4 * ch + (wgid % nig) / gsz; return true;
    }
    __device__ __forceinline__ void a_ready(const Unit&) const {}
    __device__ __forceinline__ void done(const Unit&) const {}
};

typedef __bf16 bf16x2_n __attribute__((ext_vector_type(2)));
typedef float f32x2_n __attribute__((ext_vector_type(2)));
__device__ __forceinline__ unsigned cvt_pk_bf16(float lo, float hi) { const f32x2_n v = {lo, hi}; const bf16x2_n b = __builtin_convertvector(v, bf16x2_n); return __builtin_bit_cast(unsigned, b); }
typedef _Float16 h16x2 __attribute__((ext_vector_type(2)));
__device__ __forceinline__ unsigned cvt_pk_f16(float lo, float hi) { h16x2 v = {(_Float16)lo, (_Float16)hi}; return __builtin_bit_cast(unsigned, v); }

struct EpiF32 {
    static constexpr bool PERM = false, AFTER_DRAIN = false; static constexpr int MIN_STORES = 32;
    float* O; int ldc;
    __device__ __forceinline__ void operator()(const f32x4 (&acc)[2][2][4][2], const Unit& u, int wr, int wc, int fr, int fq) const {
        const int col0 = u.pn * BM + wc * 32 + 4 * fq;
#pragma unroll
        for (int ai = 0; ai < 2; ++ai)
#pragma unroll
            for (int m = 0; m < 4; ++m) { const size_t off = (size_t)(u.pm * BM + ai * HALF + wr * 64 + m * 16 + fr) * ldc + col0;
#pragma unroll
                for (int bj = 0; bj < 2; ++bj)
#pragma unroll
                    for (int n = 0; n < 2; ++n) *(f32x4*)(O + off + bj * HALF + n * 16) = acc[ai][bj][m][n]; }
    }
};
struct EpiPart {
    static constexpr bool PERM = false, AFTER_DRAIN = false; static constexpr int MIN_STORES = 32;
    float* O;
    __device__ __forceinline__ void operator()(const f32x4 (&acc)[2][2][4][2], const Unit& u, int wr, int wc, int fr, int fq) const {
        const int col0 = wc * 32 + 4 * fq;
#pragma unroll
        for (int ai = 0; ai < 2; ++ai)
#pragma unroll
            for (int m = 0; m < 4; ++m) { const size_t off = (size_t)(u.pm * BM + ai * HALF + wr * 64 + m * 16 + fr) * 256 + col0;
#pragma unroll
                for (int bj = 0; bj < 2; ++bj)
#pragma unroll
                    for (int n = 0; n < 2; ++n) *(f32x4*)(O + off + bj * HALF + n * 16) = acc[ai][bj][m][n]; }
    }
};
template <bool BASE_F32> struct EpiResB {
    static constexpr bool PERM = true, AFTER_DRAIN = false; static constexpr int MIN_STORES = 16;
    const float* basef; bf16_t* Rb; float* SSQ; int ldc;
    __device__ __forceinline__ void operator()(const f32x4 (&acc)[2][2][4][2], const Unit& u, int wr, int wc, int fr, int fq) const {
        const int col0 = u.pn * BM + wc * 32 + 8 * fq; const int row0 = u.pm * BM + wr * 64 + fr;
        float ssv[2][4];
        if constexpr (BASE_F32) {
#pragma unroll
            for (int ai = 0; ai < 2; ++ai) { f32x4 bs[4][2][2];
#pragma unroll
                for (int m = 0; m < 4; ++m)
#pragma unroll
                    for (int bj = 0; bj < 2; ++bj) { const float* bp = basef + (size_t)(row0 + ai * HALF + m * 16) * ldc + col0 + bj * HALF; bs[m][bj][0] = *(const f32x4*)bp; bs[m][bj][1] = *(const f32x4*)(bp + 4); }
#pragma unroll
                for (int m = 0; m < 4; ++m) { float ss = 0.f;
#pragma unroll
                    for (int bj = 0; bj < 2; ++bj) { const f32x4 v0 = bs[m][bj][0] + acc[ai][bj][m][0], v1 = bs[m][bj][1] + acc[ai][bj][m][1];
                        ss += ((v0[0] * v0[0] + v0[1] * v0[1]) + (v0[2] * v0[2] + v0[3] * v0[3])) + ((v1[0] * v1[0] + v1[1] * v1[1]) + (v1[2] * v1[2] + v1[3] * v1[3]));
                        u32x4 o; o.x = cvt_pk_bf16(v0[0], v0[1]); o.y = cvt_pk_bf16(v0[2], v0[3]); o.z = cvt_pk_bf16(v1[0], v1[1]); o.w = cvt_pk_bf16(v1[2], v1[3]);
                        *(u32x4*)(Rb + (size_t)(row0 + ai * HALF + m * 16) * ldc + col0 + bj * HALF) = o; }
                    ssv[ai][m] = ss; } }
        } else {
            u32x4 ws[2][4][2];
#pragma unroll
            for (int ai = 0; ai < 2; ++ai)
#pragma unroll
                for (int m = 0; m < 4; ++m)
#pragma unroll
                    for (int bj = 0; bj < 2; ++bj) ws[ai][m][bj] = *(const u32x4*)(Rb + (size_t)(row0 + ai * HALF + m * 16) * ldc + col0 + bj * HALF);
#pragma unroll
            for (int ai = 0; ai < 2; ++ai)
#pragma unroll
                for (int m = 0; m < 4; ++m) { float ss = 0.f;
#pragma unroll
                    for (int bj = 0; bj < 2; ++bj) { const u32x4 w = ws[ai][m][bj]; f32x4 b0, b1;
                        b0[0] = __builtin_bit_cast(float, w.x << 16); b0[1] = __builtin_bit_cast(float, w.x & 0xffff0000u); b0[2] = __builtin_bit_cast(float, w.y << 16); b0[3] = __builtin_bit_cast(float, w.y & 0xffff0000u);
                        b1[0] = __builtin_bit_cast(float, w.z << 16); b1[1] = __builtin_bit_cast(float, w.z & 0xffff0000u); b1[2] = __builtin_bit_cast(float, w.w << 16); b1[3] = __builtin_bit_cast(float, w.w & 0xffff0000u);
                        const f32x4 v0 = b0 + acc[ai][bj][m][0], v1 = b1 + acc[ai][bj][m][1];
                        ss += ((v0[0] * v0[0] + v0[1] * v0[1]) + (v0[2] * v0[2] + v0[3] * v0[3])) + ((v1[0] * v1[0] + v1[1] * v1[1]) + (v1[2] * v1[2] + v1[3] * v1[3]));
                        u32x4 o; o.x = cvt_pk_bf16(v0[0], v0[1]); o.y = cvt_pk_bf16(v0[2], v0[3]); o.z = cvt_pk_bf16(v1[0], v1[1]); o.w = cvt_pk_bf16(v1[2], v1[3]);
                        *(u32x4*)(Rb + (size_t)(row0 + ai * HALF + m * 16) * ldc + col0 + bj * HALF) = o; }
                    ssv[ai][m] = ss; }
        }
#pragma unroll
        for (int ai = 0; ai < 2; ++ai)
#pragma unroll
            for (int m = 0; m < 4; ++m) { float ss = ssv[ai][m]; ss += __shfl_xor(ss, 16); ss += __shfl_xor(ss, 32); ssv[ai][m] = ss; }
        if (fq == 0) {
#pragma unroll
            for (int ai = 0; ai < 2; ++ai)
#pragma unroll
                for (int m = 0; m < 4; ++m) SSQ[(size_t)(row0 + ai * HALF + m * 16) * 16 + u.pn * 4 + wc] = ssv[ai][m];
        }
    }
};
constexpr int RSTD_OFF = STAGE_BYTES;
constexpr int RSTD_MAXU = 8;
template <class Sched>
__device__ __forceinline__ void stage_rstd(PG8_LAS unsigned char* lds, const float* SSQ, const Sched& S, int tid) {
    PG8_LAS float* dst = (PG8_LAS float*)(lds + RSTD_OFF);
    const int r = tid & 255, i0 = tid >> 8;
    f32x4 t[RSTD_MAXU / 2]; bool has[RSTD_MAXU / 2];
#pragma unroll
    for (int j = 0; j < RSTD_MAXU / 2; ++j) { Unit u; has[j] = S.next(i0 + 2 * j, u); if (!has[j]) u.pm = 0;
        const f32x4* sp = (const f32x4*)(SSQ + (size_t)(u.pm * BM + r) * 16); t[j] = (sp[0] + sp[1]) + (sp[2] + sp[3]); }
#pragma unroll
    for (int j = 0; j < RSTD_MAXU / 2; ++j) if (has[j]) dst[(i0 + 2 * j) * 256 + r] = 1.0f / __builtin_sqrtf(((t[j][0] + t[j][1]) + (t[j][2] + t[j][3])) * (1.0f / 1024.0f) + 1e-6f);
    __syncthreads();
}
__device__ __forceinline__ void row_rstd(PG8_LAS unsigned char* lds, const Unit& u, int wr, int fr, float (&rs)[2][4]) {
    const PG8_LAS float* src = (const PG8_LAS float*)(lds + RSTD_OFF) + u.ui * 256 + wr * 64 + fr;
#pragma unroll
    for (int ai = 0; ai < 2; ++ai)
#pragma unroll
        for (int m = 0; m < 4; ++m) rs[ai][m] = src[ai * HALF + m * 16];
}
struct EpiRelu2 {
    static constexpr bool PERM = true, AFTER_DRAIN = false; static constexpr int MIN_STORES = 16;
    bf16_t* O; int ldc; PG8_LAS unsigned char* L;
    __device__ __forceinline__ void operator()(const f32x4 (&acc)[2][2][4][2], const Unit& u, int wr, int wc, int fr, int fq) const {
        const int col0 = u.pn * BM + wc * 32 + 8 * fq;
        float rs[2][4]; row_rstd(L, u, wr, fr, rs);
#pragma unroll
        for (int ai = 0; ai < 2; ++ai)
#pragma unroll
            for (int m = 0; m < 4; ++m) { bf16_t* rowp = O + (size_t)(u.pm * BM + ai * HALF + wr * 64 + m * 16 + fr) * ldc + col0; const float r_ = rs[ai][m];
#pragma unroll
                for (int bj = 0; bj < 2; ++bj) { f32x4 v0 = acc[ai][bj][m][0], v1 = acc[ai][bj][m][1];
#pragma unroll
                    for (int e = 0; e < 4; ++e) { const float a = fmaxf(v0[e] * r_, 0.f), b = fmaxf(v1[e] * r_, 0.f); v0[e] = a * a; v1[e] = b * b; }
                    u32x4 w; w.x = cvt_pk_bf16(v0[0], v0[1]); w.y = cvt_pk_bf16(v0[2], v0[3]); w.z = cvt_pk_bf16(v1[0], v1[1]); w.w = cvt_pk_bf16(v1[2], v1[3]);
                    *(u32x4*)(rowp + bj * HALF) = w; } }
    }
};
template <bool F16OUT> struct EpiPk {
    static constexpr bool PERM = true, AFTER_DRAIN = false; static constexpr int MIN_STORES = 16;
    bf16_t* O; int ldc;
    __device__ __forceinline__ void operator()(const f32x4 (&acc)[2][2][4][2], const Unit& u, int wr, int wc, int fr, int fq) const {
        const int col0 = u.pn * BM + wc * 32 + 8 * fq;
#pragma unroll
        for (int ai = 0; ai < 2; ++ai)
#pragma unroll
            for (int m = 0; m < 4; ++m) { bf16_t* rowp = O + (size_t)(u.pm * BM + ai * HALF + wr * 64 + m * 16 + fr) * ldc + col0;
#pragma unroll
                for (int bj = 0; bj < 2; ++bj) { const f32x4 v0 = acc[ai][bj][m][0], v1 = acc[ai][bj][m][1]; u32x4 w;
                    if (!F16OUT) { w.x = cvt_pk_bf16(v0[0], v0[1]); w.y = cvt_pk_bf16(v0[2], v0[3]); w.z = cvt_pk_bf16(v1[0], v1[1]); w.w = cvt_pk_bf16(v1[2], v1[3]); }
                    else { w.x = cvt_pk_f16(v0[0], v0[1]); w.y = cvt_pk_f16(v0[2], v0[3]); w.z = cvt_pk_f16(v1[0], v1[1]); w.w = cvt_pk_f16(v1[2], v1[3]); }
                    *(u32x4*)(rowp + bj * HALF) = w; } }
    }
};
struct EpiPrep {
    static constexpr bool PERM = true, AFTER_DRAIN = true; static constexpr int MIN_STORES = 0;
    bf16_t* CQ; bf16_t* CKV; bf16_t* KIDX; float* WIDX; const float* gkv; const float* gk; float wscale;
    __device__ __forceinline__ void operator()(const f32x4 (&)[2][2][4][2], const Unit&, int, int, int, int) const {}
    __device__ __forceinline__ void fused(const f32x4 (&acc)[2][2][4][2], const Unit& u, int wr, int wc, int fr, int fq, PG8_LAS unsigned char* lds, int wid, int lane) const {
        PG8_LAS float* red = (PG8_LAS float*)lds;
#pragma unroll
        for (int ai = 0; ai < 2; ++ai)
#pragma unroll
            for (int m = 0; m < 4; ++m) { float p[2];
#pragma unroll
                for (int bj = 0; bj < 2; ++bj) { const f32x4 v0 = acc[ai][bj][m][0], v1 = acc[ai][bj][m][1];
                    float t = ((v0[0] * v0[0] + v0[1] * v0[1]) + (v0[2] * v0[2] + v0[3] * v0[3])) + ((v1[0] * v1[0] + v1[1] * v1[1]) + (v1[2] * v1[2] + v1[3] * v1[3]));
                    t += __shfl_xor(t, 16); t += __shfl_xor(t, 32); p[bj] = t; }
                if (fq == 0) { PG8_LAS float* d = red + ((ai * HALF + wr * 64 + m * 16 + fr) * 4 + wc) * 2; d[0] = p[0]; d[1] = p[1]; } }
        __syncthreads();
#pragma unroll
        for (int ai = 0; ai < 2; ++ai)
#pragma unroll
            for (int m = 0; m < 4; ++m) { const int rt = ai * HALF + wr * 64 + m * 16 + fr; const size_t row = (size_t)u.pm * BM + rt;
                const f32x4 ra = *(const PG8_LAS f32x4*)(red + rt * 8), rb = *(const PG8_LAS f32x4*)(red + rt * 8 + 4);
                const float t0 = (ra[0] + ra[2]) + (rb[0] + rb[2]), t1 = (ra[1] + ra[3]) + (rb[1] + rb[3]), t1k = ra[1] + ra[3];
                if (u.pn == 0) { const float r_ = 1.0f / __builtin_sqrtf((t0 + t1) * (1.0f / 256.0f) + 1e-6f);
#pragma unroll
                    for (int bj = 0; bj < 2; ++bj) { const f32x4 v0 = acc[ai][bj][m][0] * r_, v1 = acc[ai][bj][m][1] * r_; u32x4 w;
                        w.x = cvt_pk_f16(v0[0], v0[1]); w.y = cvt_pk_f16(v0[2], v0[3]); w.z = cvt_pk_f16(v1[0], v1[1]); w.w = cvt_pk_f16(v1[2], v1[3]);
                        *(u32x4*)(CQ + row * 256 + bj * HALF + wc * 32 + 8 * fq) = w; }
                } else {
                    { const float r_ = 1.0f / __builtin_sqrtf(t0 * (1.0f / 128.0f) + 1e-6f); const int c = wc * 32 + 8 * fq;
                      const f32x4 g0 = *(const f32x4*)(gkv + c), g1 = *(const f32x4*)(gkv + c + 4); const f32x4 v0 = acc[ai][0][m][0] * r_ * g0, v1 = acc[ai][0][m][1] * r_ * g1; u32x4 w;
                      w.x = cvt_pk_bf16(v0[0], v0[1]); w.y = cvt_pk_bf16(v0[2], v0[3]); w.z = cvt_pk_bf16(v1[0], v1[1]); w.w = cvt_pk_bf16(v1[2], v1[3]);
                      *(u32x4*)(CKV + row * 128 + c) = w; }
                    if (wc < 2) { const float r_ = 1.0f / __builtin_sqrtf(t1k * (1.0f / 64.0f) + 1e-6f); const int c = wc * 32 + 8 * fq;
                      const f32x4 g0 = *(const f32x4*)(gk + c), g1 = *(const f32x4*)(gk + c + 4); const f32x4 v0 = acc[ai][1][m][0] * r_ * g0, v1 = acc[ai][1][m][1] * r_ * g1; u32x4 w;
                      w.x = cvt_pk_f16(v0[0], v0[1]); w.y = cvt_pk_f16(v0[2], v0[3]); w.z = cvt_pk_f16(v1[0], v1[1]); w.w = cvt_pk_f16(v1[2], v1[3]);
                      *(u32x4*)(KIDX + row * 64 + c) = w; }
                    else if (wc == 2 && fq == 0) { *(f32x4*)(WIDX + row * 8) = acc[ai][1][m][0] * wscale; *(f32x4*)(WIDX + row * 8 + 4) = acc[ai][1][m][1] * wscale; }
                } }
    }
};
struct EpiKVQ {
    static constexpr bool PERM = true, AFTER_DRAIN = false; static constexpr int MIN_STORES = 16;
    bf16_t* KV; bf16_t* QN; PG8_LAS unsigned char* L; bf16_t* FLAT; const float* posk; const float* posv;
    __device__ __forceinline__ void operator()(const f32x4 (&acc)[2][2][4][2], const Unit& u, int wr, int wc, int fr, int fq) const {
        float rs[2][4]; row_rstd(L, u, wr, fr, rs);
        if (u.pn < 2) {
            const int part = u.pn; const float* pos = part ? posv : posk; const int d = wc * 32 + 8 * fq;
            const f32x4 pA0 = *(const f32x4*)(pos + fr * 128 + d), pA1 = *(const f32x4*)(pos + fr * 128 + d + 4), pB0 = *(const f32x4*)(pos + (fr + 16) * 128 + d), pB1 = *(const f32x4*)(pos + (fr + 16) * 128 + d + 4);
#pragma unroll
            for (int ai = 0; ai < 2; ++ai)
#pragma unroll
                for (int m = 0; m < 4; ++m) { const int mrow = u.pm * BM + ai * HALF + wr * 64 + m * 16 + fr, b = mrow >> 13, t = mrow & 8191, nA = t >> 4; const float r_ = rs[ai][m];
#pragma unroll
                    for (int bj = 0; bj < 2; ++bj) { const f32x4 v0 = acc[ai][bj][m][0] * r_, v1 = acc[ai][bj][m][1] * r_;
                        const unsigned w0 = cvt_pk_bf16(v0[0], v0[1]), w1 = cvt_pk_bf16(v0[2], v0[3]), w2 = cvt_pk_bf16(v1[0], v1[1]), w3 = cvt_pk_bf16(v1[2], v1[3]);
#pragma unroll
                        for (int win = 0; win < 2; ++win) { const int n = nA - win, j = fr + 16 * win; const f32x4 p0 = win ? pB0 : pA0, p1 = win ? pB1 : pA1;
                            if (n >= 0 && n <= 510) { u32x4 o;
                                o.x = cvt_pk_bf16(__builtin_bit_cast(float, w0 << 16) + p0[0], __builtin_bit_cast(float, w0 & 0xffff0000u) + p0[1]);
                                o.y = cvt_pk_bf16(__builtin_bit_cast(float, w1 << 16) + p0[2], __builtin_bit_cast(float, w1 & 0xffff0000u) + p0[3]);
                                o.z = cvt_pk_bf16(__builtin_bit_cast(float, w2 << 16) + p1[0], __builtin_bit_cast(float, w2 & 0xffff0000u) + p1[1]);
                                o.w = cvt_pk_bf16(__builtin_bit_cast(float, w3 << 16) + p1[2], __builtin_bit_cast(float, w3 & 0xffff0000u) + p1[3]);
                                *(u32x4*)(FLAT + ((size_t)((part * 4 + (j >> 3)) * 4096 + (b * 511 + n) * 2 + bj) * 1024 + (j & 7) * 128 + d)) = o; } } } }
            return;
        }
        const bool iskv = u.pn < 6; const int ldc = iskv ? 1536 : 1024; bf16_t* base = iskv ? KV : QN;
        const int col0 = (iskv ? u.pn : u.pn - 6) * BM + wc * 32 + 8 * fq;
#pragma unroll
        for (int ai = 0; ai < 2; ++ai)
#pragma unroll
            for (int m = 0; m < 4; ++m) { bf16_t* rowp = base + (size_t)(u.pm * BM + ai * HALF + wr * 64 + m * 16 + fr) * ldc + col0; const float r_ = rs[ai][m];
#pragma unroll
                for (int bj = 0; bj < 2; ++bj) { const f32x4 v0 = acc[ai][bj][m][0] * r_, v1 = acc[ai][bj][m][1] * r_; u32x4 w;
                    w.x = cvt_pk_bf16(v0[0], v0[1]); w.y = cvt_pk_bf16(v0[2], v0[3]); w.z = cvt_pk_bf16(v1[0], v1[1]); w.w = cvt_pk_bf16(v1[2], v1[3]);
                    *(u32x4*)(rowp + bj * HALF) = w; } }
    }
};
struct EpiGate {
    static constexpr bool PERM = true, AFTER_DRAIN = false; static constexpr int MIN_STORES = 0;
    float* GATES; PG8_LAS unsigned char* L;
    __device__ __forceinline__ void operator()(const f32x4 (&acc)[2][2][4][2], const Unit& u, int wr, int wc, int fr, int fq) const {
        float rs[2][4]; row_rstd(L, u, wr, fr, rs);
        if (wc == 0 && fq < 3) {
#pragma unroll
            for (int ai = 0; ai < 2; ++ai)
#pragma unroll
                for (int m = 0; m < 4; ++m) { float* rowp = GATES + (size_t)(u.pm * BM + ai * HALF + wr * 64 + m * 16 + fr) * 24 + 8 * fq; const float r_ = rs[ai][m];
#pragma unroll
                    for (int n = 0; n < 2; ++n) { f32x4 v = acc[ai][0][m][n];
#pragma unroll
                        for (int e = 0; e < 4; ++e) v[e] = 1.0f / (1.0f + __expf(-v[e] * r_));
                        *(f32x4*)(rowp + 4 * n) = v; } }
        }
    }
};
typedef _Float16 f16x8 __attribute__((ext_vector_type(8)));
__device__ __forceinline__ f32x4 mma16(bf16x8 a, bf16x8 b, f32x4 c, std::false_type) { return __builtin_amdgcn_mfma_f32_16x16x32_bf16(a, b, c, 0, 0, 0); }
__device__ __forceinline__ f32x4 mma16(bf16x8 a, bf16x8 b, f32x4 c, std::true_type) { return __builtin_amdgcn_mfma_f32_16x16x32_f16(__builtin_bit_cast(f16x8, a), __builtin_bit_cast(f16x8, b), c, 0, 0, 0); }
template <class Epi, class Sched, bool ALIGN_EPI = false, bool SP2 = false, bool F16 = false>
__device__ __forceinline__ void gemm_phase(PG8_LAS unsigned char* lds, const Gemm g, const Sched& S, const Epi& E, const int wave_sgpr, const float* rstd_ssq = nullptr) {
    const int lane = lane_id_asm(), wid = wave_sgpr, tid = wid * 64 + lane,
              wr = wid >> 2, wc = wid & 3, fr = lane & 15, fq = lane >> 4;
    const int K = g.K, nt = K / BK;
    unsigned voffA[2], voffB[2];
#pragma unroll
    for (int i = 0; i < 2; ++i) { int R, C; stage_rc(tid * 16 + i * 8192, R, C); const int Rb = Epi::PERM ? ((R & ~31) + perm32(R & 31)) : R;
        voffA[i] = (unsigned)(R * K + C) * 2u; voffB[i] = (unsigned)(Rb * K + C) * 2u; }
    const size_t kstep = (size_t)(BK * 2);
    const size_t hstep = (size_t)HALF * K * 2;
    const size_t tstep = 2 * hstep;
    const unsigned ldsw = (unsigned)wid * 1024u;
    const int aoff = lds_byte(wr * 64 + fr, fq * 8), boff = lds_byte(wc * 32 + fr, fq * 8);
#define PG8_SA(b, h) (((b) * 2 + (h)) * HTB)
#define PG8_SB(b, h) ((4 + (b) * 2 + (h)) * HTB)
#define PG8_STAGE(bufoff, gbase, voff) do { _Pragma("unroll") for (int _i = 0; _i < 2; ++_i) \
        __builtin_amdgcn_global_load_lds((const unsigned*)((const char*)(gbase) + (voff)[_i]), (PG8_LAS unsigned*)(lds + (bufoff) + ldsw + _i * 8192), 16, 0, 0); } while (0)
#define PG8_LDA(dst, b, h) do { _Pragma("unroll") for (int m = 0; m < 4; ++m) _Pragma("unroll") for (int k = 0; k < 2; ++k) dst[m][k] = *(const PG8_LAS bf16x8*)(lds + PG8_SA(b, h) + aoff + m * 2048 + k * 1024); } while (0)
#define PG8_LDB(dst, b, h) do { _Pragma("unroll") for (int n = 0; n < 2; ++n) _Pragma("unroll") for (int k = 0; k < 2; ++k) dst[n][k] = *(const PG8_LAS bf16x8*)(lds + PG8_SB(b, h) + boff + n * 2048 + k * 1024); } while (0)
#define PG8_MMA(ai, bj, At, Bt) do { __builtin_amdgcn_s_setprio(1); _Pragma("unroll") for (int m = 0; m < 4; ++m) _Pragma("unroll") for (int n = 0; n < 2; ++n) _Pragma("unroll") for (int k = 0; k < 2; ++k) \
        acc[ai][bj][m][n] = mma16(Bt[n][k], At[m][k], acc[ai][bj][m][n], std::integral_constant<bool, F16>()); __builtin_amdgcn_s_setprio(0); } while (0)
#define PG8_WAIT_V(n) asm volatile("s_waitcnt vmcnt(" #n ")" ::: "memory")
#define PG8_WAIT_VN(n) asm volatile("s_waitcnt vmcnt(%0)" :: "n"(n) : "memory")
#define PG8_WAIT_L(n) asm volatile("s_waitcnt lgkmcnt(" #n ")" ::: "memory")
#define PG8_BAR __builtin_amdgcn_s_barrier()
#define PG8_SCHED __builtin_amdgcn_sched_barrier(0)
    Unit cur, nxt; int ui = 0;
    if (!S.next(0, cur)) return;
    cur.ui = 0;
    f32x4 acc[2][2][4][2];
#pragma unroll
    for (int a = 0; a < 2; ++a)
#pragma unroll
        for (int b = 0; b < 2; ++b)
#pragma unroll
            for (int m = 0; m < 4; ++m)
#pragma unroll
                for (int n = 0; n < 2; ++n) acc[a][b][m][n] = (f32x4){0.f, 0.f, 0.f, 0.f};
    bf16x8 At[4][2], B0[2][2], B1[2][2];
    const char* cA = (const char*)g.A + (size_t)cur.pm * tstep; const char* cB = (const char*)g.Bt + (size_t)cur.pn * tstep;
    S.a_ready(cur);
    if constexpr (SP2) {
        PG8_STAGE(PG8_SB(0, 0), cB, voffB); PG8_STAGE(PG8_SB(0, 1), cB + hstep, voffB); PG8_STAGE(PG8_SA(0, 0), cA, voffA); PG8_STAGE(PG8_SA(0, 1), cA + hstep, voffA);
        if (rstd_ssq) stage_rstd(lds, rstd_ssq, S, tid);
        if (wr == 1) PG8_BAR;
        PG8_WAIT_V(2); PG8_BAR;
        PG8_STAGE(PG8_SB(1, 0), cB + kstep, voffB); PG8_STAGE(PG8_SA(1, 0), cA + kstep, voffA); PG8_STAGE(PG8_SB(1, 1), cB + hstep + kstep, voffB);
        PG8_WAIT_V(6); PG8_BAR;
    } else {
        PG8_STAGE(PG8_SB(0, 0), cB, voffB); PG8_STAGE(PG8_SA(0, 0), cA, voffA); PG8_STAGE(PG8_SB(0, 1), cB + hstep, voffB); PG8_STAGE(PG8_SA(0, 1), cA + hstep, voffA);
        if (wr == 1) PG8_BAR;
        PG8_WAIT_V(4); PG8_BAR;
        PG8_STAGE(PG8_SB(1, 0), cB + kstep, voffB); PG8_STAGE(PG8_SA(1, 0), cA + kstep, voffA); PG8_STAGE(PG8_SB(1, 1), cB + hstep + kstep, voffB);
        PG8_WAIT_V(6); PG8_BAR;
    }
    for (;;) {
        const bool has_next = S.next(ui + 1, nxt); nxt.ui = ui + 1;
        const char* nA = has_next ? (const char*)g.A + (size_t)nxt.pm * tstep : cA; const char* nB = has_next ? (const char*)g.Bt + (size_t)nxt.pn * tstep : cB;
#pragma unroll 1
        for (int t = 0; t < nt; t += 2) {
            const bool last = (t == nt - 2);
            const char* a1 = cA + (size_t)(t + 1) * kstep;
            const char* a2 = last ? nA : cA + (size_t)(t + 2) * kstep; const char* b2 = last ? nB : cB + (size_t)(t + 2) * kstep;
            const char* a3 = a2 + kstep; const char* b3 = b2 + kstep;
            if (last && has_next) S.a_ready(nxt);
            if constexpr (SP2) {
            const bool after_epi = (t == 0) && (ui > 0) && (Epi::MIN_STORES > 0) && !Epi::AFTER_DRAIN;
            PG8_LDB(B0, 0, 0); PG8_LDB(B1, 0, 1); PG8_SCHED; PG8_LDA(At, 0, 0); PG8_STAGE(PG8_SA(1, 1), a1 + hstep, voffA);
            if (after_epi) PG8_WAIT_VN(8 + Epi::MIN_STORES); else PG8_WAIT_V(8);
            PG8_WAIT_L(0); PG8_BAR; PG8_MMA(0, 0, At, B0); PG8_MMA(0, 1, At, B1); PG8_BAR; PG8_SCHED;
            const bool tail = last && !has_next;
            PG8_LDA(At, 0, 1); if (!tail) { PG8_STAGE(PG8_SB(0, 0), b2, voffB); PG8_STAGE(PG8_SB(0, 1), b2 + hstep, voffB); PG8_STAGE(PG8_SA(0, 0), a2, voffA); }
            if (tail) PG8_WAIT_V(2); else if (after_epi) PG8_WAIT_VN(8 + Epi::MIN_STORES); else PG8_WAIT_V(8);
            PG8_WAIT_L(0); PG8_BAR; PG8_MMA(1, 0, At, B0); PG8_MMA(1, 1, At, B1); PG8_BAR; PG8_SCHED;
            PG8_LDB(B0, 1, 0); PG8_LDB(B1, 1, 1); PG8_SCHED; PG8_LDA(At, 1, 0); if (!tail) PG8_STAGE(PG8_SA(0, 1), a2 + hstep, voffA);
            if (tail) PG8_WAIT_V(0); else PG8_WAIT_V(8);
            PG8_WAIT_L(0); PG8_BAR; PG8_MMA(0, 0, At, B0); PG8_MMA(0, 1, At, B1); PG8_BAR; PG8_SCHED;
            PG8_LDA(At, 1, 1); if (!tail) { PG8_STAGE(PG8_SB(1, 0), b3, voffB); PG8_STAGE(PG8_SB(1, 1), b3 + hstep, voffB); PG8_STAGE(PG8_SA(1, 0), a3, voffA); }
            if (!tail) PG8_WAIT_V(8);
            PG8_WAIT_L(0); PG8_BAR; PG8_MMA(1, 0, At, B0); PG8_MMA(1, 1, At, B1); PG8_BAR; PG8_SCHED;
            } else {
            PG8_LDB(B0, 0, 0); PG8_SCHED; PG8_LDA(At, 0, 0); PG8_STAGE(PG8_SA(1, 1), a1 + hstep, voffA);
            PG8_WAIT_L(8); PG8_BAR; PG8_WAIT_L(0); PG8_MMA(0, 0, At, B0); PG8_BAR; PG8_SCHED;
            PG8_LDB(B1, 0, 1); PG8_STAGE(PG8_SB(0, 0), b2, voffB);
            PG8_BAR; PG8_WAIT_L(0); PG8_MMA(0, 1, At, B1); PG8_BAR;
            PG8_LDA(At, 0, 1); PG8_STAGE(PG8_SA(0, 0), a2, voffA);
            PG8_BAR; PG8_WAIT_L(0); PG8_MMA(1, 0, At, B0); PG8_BAR; PG8_SCHED;
            PG8_STAGE(PG8_SB(0, 1), b2 + hstep, voffB);
            PG8_WAIT_V(6); PG8_BAR; PG8_MMA(1, 1, At, B1); PG8_BAR;
            PG8_LDB(B0, 1, 0); PG8_SCHED; PG8_LDA(At, 1, 0); PG8_STAGE(PG8_SA(0, 1), a2 + hstep, voffA);
            PG8_WAIT_L(8); PG8_BAR; PG8_WAIT_L(0); PG8_MMA(0, 0, At, B0); PG8_BAR; PG8_SCHED;
            PG8_LDB(B1, 1, 1); PG8_STAGE(PG8_SB(1, 0), b3, voffB);
            PG8_BAR; PG8_WAIT_L(0); PG8_MMA(0, 1, At, B1); PG8_BAR;
            PG8_LDA(At, 1, 1); PG8_STAGE(PG8_SA(1, 0), a3, voffA);
            PG8_BAR; PG8_WAIT_L(0); PG8_MMA(1, 0, At, B0); PG8_BAR; PG8_SCHED;
            PG8_STAGE(PG8_SB(1, 1), b3 + hstep, voffB);
            PG8_WAIT_V(6); PG8_BAR; PG8_MMA(1, 1, At, B1); PG8_BAR;
            }
        }
        if constexpr (ALIGN_EPI) { if (wr == 0) PG8_BAR; }
        if constexpr (!Epi::AFTER_DRAIN) { E(acc, cur, wr, wc, fr, fq); S.done(cur); }
        if (!has_next) break;
#pragma unroll
        for (int a = 0; a < 2; ++a)
#pragma unroll
            for (int b = 0; b < 2; ++b)
#pragma unroll
                for (int m = 0; m < 4; ++m)
#pragma unroll
                    for (int n = 0; n < 2; ++n) acc[a][b][m][n] = (f32x4){0.f, 0.f, 0.f, 0.f};
        cur = nxt; cA = nA; cB = nB; ++ui;
        if constexpr (ALIGN_EPI) { if (wr == 1) PG8_BAR; }
    }
    PG8_WAIT_V(0);
    if constexpr (!ALIGN_EPI) { if (wr == 0) PG8_BAR; }
    PG8_BAR;
    if constexpr (Epi::AFTER_DRAIN) { E.fused(acc, cur, wr, wc, fr, fq, lds, wid, lane); S.done(cur); }
#undef PG8_SA
#undef PG8_SB
#undef PG8_STAGE
#undef PG8_LDA
#undef PG8_LDB
#undef PG8_MMA
#undef PG8_WAIT_V
#undef PG8_WAIT_VN
#undef PG8_WAIT_L
#undef PG8_BAR
#undef PG8_SCHED
}
}

constexpr int NWAVES = 8, NTHR = 512;
constexpr int BATCH = 4, T = 8192, D = 1024, M = BATCH * T, FF = 4096;
constexpr int PW = 456, QPW = 1048, KVW = 1536, NCMP = 511;
constexpr float NEGF = -1e30f;
constexpr float QK_SCALE = 0.08838834764831845f;
constexpr float WIDX_SCALE = 0.04419417382415922f;
constexpr size_t MiB = 1u << 20;
constexpr size_t WS_BIASV = 1 * MiB;
constexpr size_t WS_W_IN0 = 2 * MiB;
constexpr size_t WS_W_Q2 = 3 * MiB;
constexpr size_t WS_W_UVO = 4 * MiB;
constexpr size_t WS_W_UP = 6 * MiB;
constexpr size_t WS_W_DN = 22 * MiB;
constexpr size_t WS_W_KVQ = 38 * MiB;
constexpr size_t WS_W_O1 = 44 * MiB;
constexpr size_t WS_W_C1 = 46 * MiB;
constexpr size_t WS_CBIAS = 50 * MiB;
constexpr size_t WS_SSQ = 52 * MiB;
constexpr size_t WS_RB = 448 * MiB;
constexpr size_t WS_XN = 64 * MiB;
constexpr size_t WS_S = 128 * MiB;
constexpr size_t WS_PROJ0 = WS_S;
constexpr size_t WS_CQ = WS_S + 64 * MiB;
constexpr size_t WS_CKV = WS_S + 80 * MiB;
constexpr size_t WS_KIDX = WS_S + 88 * MiB;
constexpr size_t WS_WIDX = WS_S + 92 * MiB;
constexpr size_t WS_QIDX = WS_S + 96 * MiB;
constexpr size_t WS_QABS = WS_S + 128 * MiB;
constexpr size_t WS_SEL = WS_S + 192 * MiB;
constexpr size_t WS_U = WS_S;
constexpr size_t WS_KV = WS_S;
constexpr size_t WS_QN = WS_S + 98 * MiB;
constexpr size_t WS_GATES = WS_S + 162 * MiB;
constexpr size_t WS_KC = WS_S + 166 * MiB;
constexpr size_t WS_VC = WS_S + 167 * MiB;
constexpr size_t WS_FLAT = 384 * MiB;
constexpr size_t WS_PART = 300 * MiB;
constexpr size_t WS_END = 512 * MiB;
constexpr int RING_BYTES = 131072, LDS_BYTES = 155648;

#define GAS __attribute__((address_space(1)))
#define LAS __attribute__((address_space(3)))
typedef unsigned short bf16;
typedef unsigned v4u __attribute__((ext_vector_type(4)));
typedef unsigned v2u __attribute__((ext_vector_type(2)));
typedef float f32x4 __attribute__((ext_vector_type(4)));
typedef float f32x2 __attribute__((ext_vector_type(2)));
#define LDS_WAIT() asm volatile("s_waitcnt lgkmcnt(0)" ::: "memory")
__device__ __forceinline__ unsigned f2bf(float f) { unsigned u = __builtin_bit_cast(unsigned, f); return (u + 0x7fffu + ((u >> 16) & 1u)) >> 16; }
__device__ __forceinline__ unsigned pk2(float lo, float hi) {
    typedef float pk2_f2 __attribute__((ext_vector_type(2))); typedef __bf16 pk2_b2 __attribute__((ext_vector_type(2)));
    const pk2_f2 v = {lo, hi}; const pk2_b2 b = __builtin_convertvector(v, pk2_b2); return __builtin_bit_cast(unsigned, b); }
__device__ __forceinline__ unsigned short f2h_(float f) { return __builtin_bit_cast(unsigned short, (_Float16)f); }
__device__ __forceinline__ unsigned pkh2(float lo, float hi) { return (unsigned)f2h_(lo) | ((unsigned)f2h_(hi) << 16); }
__device__ __forceinline__ unsigned pk2x(float lo, float hi, bool f16) { return f16 ? pkh2(lo, hi) : pk2(lo, hi); }
__device__ __forceinline__ float bf2f(unsigned short b) { return __builtin_bit_cast(float, (unsigned)b << 16); }
__device__ __forceinline__ float bflo(unsigned w) { return __builtin_bit_cast(float, w << 16); }
__device__ __forceinline__ float bfhi(unsigned w) { return __builtin_bit_cast(float, w & 0xffff0000u); }
__device__ __forceinline__ float h2f(unsigned short h) { return (float)__builtin_bit_cast(_Float16, h); }
__device__ __forceinline__ unsigned short f2h(float f) { return __builtin_bit_cast(unsigned short, (_Float16)f); }
__device__ __forceinline__ float wave_sum(float v) {
#pragma unroll
    for (int o = 1; o < 64; o <<= 1) v += __shfl_xor(v, o);
    return v;
}
__device__ __forceinline__ float wave_max(float v) {
#pragma unroll
    for (int o = 1; o < 64; o <<= 1) v = fmaxf(v, __shfl_xor(v, o));
    return v;
}
__device__ __forceinline__ int rel_bucket(int dist) {
    if (dist < 16) return dist < 0 ? 0 : dist;
    const int v = 39 - __clz(dist * dist);
    return v > 31 ? 31 : v;
}

struct Params {
    const float* in[26]; float* out; unsigned char* ws; int ph_lo, ph_hi;
};
struct Frame { LAS unsigned char* lds; int tid, lane, wave, G, gw, NGW; };

struct TrDesc { const float* W; int ldw, Nreal, K; bf16* WT; int row_off; const float* gain; float sc; int sc_cols, item, nblk; bool f16; };
__device__ __forceinline__ void tr_load(const TrDesc& d, int lane, f32x4 (&v)[8], float (&gv)[8]) {
    const int kb = d.item / d.nblk, nb = d.item % d.nblk, k0 = 64 * kb, n = 32 * nb + 4 * (lane & 7), kr = lane >> 3;
#pragma unroll
    for (int i = 0; i < 8; ++i) { const int kk = 8 * i + kr; f32x4 z = {0.f, 0.f, 0.f, 0.f};
        v[i] = (n < d.Nreal) ? *(const f32x4*)(d.W + (size_t)(k0 + kk) * d.ldw + n) : z; gv[i] = d.gain ? d.gain[k0 + kk] : 1.0f; }
}
__device__ __forceinline__ void tr_finish(const TrDesc& d, LAS float* scr, int lane, const f32x4 (&v)[8], const float (&gv)[8]) {
    const int kb = d.item / d.nblk, nb = d.item % d.nblk, k0 = 64 * kb, n0 = 32 * nb, n4 = 4 * (lane & 7), kr = lane >> 3;
    const float scl = (n0 + n4 < d.sc_cols) ? d.sc : 1.0f;
#pragma unroll
    for (int i = 0; i < 8; ++i) { const int kk = 8 * i + kr; const float g = gv[i] * scl; LAS float* p = scr + kk * 33 + n4;
        p[0] = v[i].x * g; p[1] = v[i].y * g; p[2] = v[i].z * g; p[3] = v[i].w * g; }
    LDS_WAIT(); asm volatile("" ::: "memory");
    const int c = lane & 7;
#pragma unroll
    for (int j = 0; j < 4; ++j) { const int n = (lane >> 3) + 8 * j; const LAS float* sp = scr + (8 * c) * 33 + n;
        float t[8];
#pragma unroll
        for (int e = 0; e < 8; ++e) t[e] = sp[e * 33];
        v4u o;
        if (d.f16) { o.x = pkh2(t[0], t[1]); o.y = pkh2(t[2], t[3]); o.z = pkh2(t[4], t[5]); o.w = pkh2(t[6], t[7]); }
        else       { o.x = pk2(t[0], t[1]);  o.y = pk2(t[2], t[3]);  o.z = pk2(t[4], t[5]);  o.w = pk2(t[6], t[7]); }
        *(v4u*)(d.WT + (size_t)(d.row_off + n0 + n) * d.K + k0 + 8 * c) = o; }
    LDS_WAIT(); asm volatile("" ::: "memory");
}
__device__ __forceinline__ void norm_row_bf16(const float* xrow, bf16* orow, int lane, bool f16 = false) {
    const f32x4* xr = (const f32x4*)xrow + lane;
    f32x4 v[4]; float s = 0.f;
#pragma unroll
    for (int j = 0; j < 4; ++j) { v[j] = xr[64 * j]; s += (v[j].x * v[j].x + v[j].y * v[j].y) + (v[j].z * v[j].z + v[j].w * v[j].w); }
    const float r = 1.0f / sqrtf(wave_sum(s) * (1.f / D) + 1e-6f);
    v2u* o8 = (v2u*)orow + lane;
#pragma unroll
    for (int j = 0; j < 4; ++j) { v2u w; w.x = pk2x(v[j].x * r, v[j].y * r, f16); w.y = pk2x(v[j].z * r, v[j].w * r, f16); o8[64 * j] = w; }
}
__device__ __forceinline__ void ph_norm(const Frame& F, const float* X, bf16* XN, bool f16 = false) {
    for (int m = F.gw; m < M; m += 4 * F.NGW) {
        f32x4 v[4][4]; float ss[4];
#pragma unroll
        for (int rr = 0; rr < 4; ++rr) { const f32x4* xa = (const f32x4*)(X + (size_t)(m + rr * F.NGW) * D) + F.lane;
#pragma unroll
            for (int j = 0; j < 4; ++j) v[rr][j] = xa[64 * j]; }
#pragma unroll
        for (int rr = 0; rr < 4; ++rr) { float sa = 0.f;
#pragma unroll
            for (int j = 0; j < 4; ++j) sa += (v[rr][j].x * v[rr][j].x + v[rr][j].y * v[rr][j].y) + (v[rr][j].z * v[rr][j].z + v[rr][j].w * v[rr][j].w);
            ss[rr] = sa; }
#pragma unroll
        for (int o = 1; o < 64; o <<= 1) {
#pragma unroll
            for (int rr = 0; rr < 4; ++rr) ss[rr] += __shfl_xor(ss[rr], o); }
#pragma unroll
        for (int rr = 0; rr < 4; ++rr) { const float ra = 1.0f / sqrtf(ss[rr] * (1.f / D) + 1e-6f); v2u* oa = (v2u*)(XN + (size_t)(m + rr * F.NGW) * D) + F.lane;
#pragma unroll
            for (int j = 0; j < 4; ++j) { v2u wa; wa.x = pk2x(v[rr][j].x * ra, v[rr][j].y * ra, f16); wa.y = pk2x(v[rr][j].z * ra, v[rr][j].w * ra, f16); oa[64 * j] = wa; } }
    }
}
__device__ __forceinline__ void ph_final_norm(const Frame& F, const bf16* Rb, const float* SSQ, float* out, const float* g) {
    f32x4 ggv[4];
#pragma unroll
    for (int j = 0; j < 4; ++j) ggv[j] = ((const f32x4*)g + F.lane)[64 * j];
    for (int m = F.gw; m < M; m += 4 * F.NGW) {
        f32x4 t[4]; v2u w[4][4];
#pragma unroll
        for (int rr = 0; rr < 4; ++rr) { const size_t mr = (size_t)(m + rr * F.NGW); if (mr >= (size_t)M) break;
            const f32x4* sp = (const f32x4*)(SSQ + mr * 16); t[rr] = (sp[0] + sp[1]) + (sp[2] + sp[3]);
            const v2u* xr = (const v2u*)(Rb + mr * D) + F.lane;
#pragma unroll
            for (int j = 0; j < 4; ++j) w[rr][j] = xr[64 * j]; }
#pragma unroll
        for (int rr = 0; rr < 4; ++rr) { if (m + rr * F.NGW >= M) break;
            const float r = 1.0f / sqrtf(((t[rr][0] + t[rr][1]) + (t[rr][2] + t[rr][3])) * (1.f / D) + 1e-6f);
            f32x4* orow = (f32x4*)(out + (size_t)(m + rr * F.NGW) * D) + F.lane;
#pragma unroll
            for (int j = 0; j < 4; ++j) { const f32x4 gg = ggv[j]; f32x4 o;
                o.x = bflo(w[rr][j].x) * r * gg.x; o.y = bfhi(w[rr][j].x) * r * gg.y; o.z = bflo(w[rr][j].y) * r * gg.z; o.w = bfhi(w[rr][j].y) * r * gg.w; orow[64 * j] = o; }
        }
    }
}

__device__ __forceinline__ void ph_prologue(const Frame& F, const Params& P) {
    unsigned char* ws = P.ws;
    LAS float* scr = (LAS float*)(F.lds + F.wave * 16384);
    const float* g_attn = P.in[1]; const float* g_mlp = P.in[2];
    constexpr int I_IN0 = 16 * 16, I_UP = 16 * 128, I_DN = 64 * 32, I_KV = 16 * 48, I_IN1 = 16 * 40, I_O1 = 16 * 32, I_QI = 4 * 16, I_C1 = 16 * 8;
    constexpr int NITEMS = I_IN0 + 2 * I_UP + 2 * I_DN + I_KV + I_IN1 + I_O1 + I_QI + 8 * I_C1;
    auto decode = [&](int it, TrDesc& d) -> bool {
        if (it >= NITEMS) return false;
        int r = it;
        if (r < I_IN0) { d = TrDesc{P.in[6], PW, PW, D, (bf16*)(ws + WS_W_IN0), 0, g_attn, 1.f, 0, r, 16, true}; return true; } r -= I_IN0;
        if (r < 2 * I_UP) { const int l = r / I_UP; r -= l * I_UP; d = TrDesc{P.in[3] + (size_t)l * D * FF, FF, FF, D, (bf16*)(ws + WS_W_UP) + (size_t)l * FF * D, 0, g_mlp + l * D, 1.f, 0, r, 128, false}; return true; } r -= 2 * I_UP;
        if (r < 2 * I_DN) { const int l = r / I_DN; r -= l * I_DN; d = TrDesc{P.in[4] + (size_t)l * FF * D, D, D, FF, (bf16*)(ws + WS_W_DN) + (size_t)l * D * FF, 0, nullptr, 1.f, 0, r, 32, false}; return true; } r -= 2 * I_DN;
        if (r < I_KV) { d = TrDesc{P.in[16], KVW, KVW, D, (bf16*)(ws + WS_W_KVQ), 0, P.in[15], 1.f, 0, r, 48, false}; return true; } r -= I_KV;
        if (r < I_IN1) { d = TrDesc{P.in[23], QPW, QPW, D, (bf16*)(ws + WS_W_KVQ), KVW, g_attn + D, QK_SCALE * 1.4426950408889634f  , 1024, r, 40, false}; return true; } r -= I_IN1;
        if (r < I_O1) { d = TrDesc{P.in[24], D, D, D, (bf16*)(ws + WS_W_O1), 0, nullptr, 1.f, 0, r, 32, false}; return true; } r -= I_O1;
        if (r < I_QI) { d = TrDesc{P.in[11], 512, 512, 256, (bf16*)(ws + WS_W_Q2), 1024, P.in[7], 1.f, 0, r, 16, true}; return true; } r -= I_QI;
        { const int sl = r / I_C1; r -= sl * I_C1; const int part = sl >> 2, ks = sl & 3;
          d = TrDesc{P.in[part ? 21 : 19] + (size_t)ks * 1024 * 256, 256, 256, 1024, (bf16*)(ws + WS_W_C1) + (size_t)sl * 256 * 1024, 0, nullptr, 1.f, 0, r, 8, false}; return true; }
    };
    {
        TrDesc dc, dn; f32x4 vc[8], vn[8]; float gc[8], gn[8];
        int it = F.gw; bool hc = decode(it, dc);
        if (hc) tr_load(dc, F.lane, vc, gc);
#pragma unroll 1
        while (hc) {
            const bool hn = decode(it + F.NGW, dn);
            if (hn) tr_load(dn, F.lane, vn, gn);
            tr_finish(dc, scr, F.lane, vc, gc);
            dc = dn; hc = hn; it += F.NGW;
#pragma unroll
            for (int i = 0; i < 8; ++i) { vc[i] = vn[i]; gc[i] = gn[i]; }
        }
    }
    {
        const float* w_uq = P.in[10]; const float* w_uk = P.in[12]; const float* gq = P.in[7]; unsigned short* WQ = (unsigned short*)(ws + WS_W_Q2);
        const int fr = F.lane & 15, fq = F.lane >> 4;
        for (int tile = F.gw; tile < 1024; tile += F.NGW) {
            const int h = tile >> 7, rt = (tile >> 3) & 15, ct = tile & 7;
            const float* ap = w_uq + (size_t)(rt * 16 + fr) * 1024 + h * 128 + 4 * fq; const float* bp = w_uk + (size_t)(ct * 16 + fr) * 1024 + h * 128 + 4 * fq;
            f32x4 av[8], bv[8];
#pragma unroll
            for (int sx = 0; sx < 8; ++sx) { av[sx] = *(const f32x4*)(ap + 16 * sx); bv[sx] = *(const f32x4*)(bp + 16 * sx); }
            f32x4 acc = {0.f, 0.f, 0.f, 0.f};
#pragma unroll
            for (int sx = 0; sx < 8; ++sx)
#pragma unroll
                for (int e = 0; e < 4; ++e) acc = __builtin_amdgcn_mfma_f32_16x16x4f32(av[sx][e], bv[sx][e], acc, 0, 0, 0);
            const f32x4 g4 = *(const f32x4*)(gq + rt * 16 + 4 * fq); const float sc = QK_SCALE * 1.4426950408889634f;
            v2u o; o.x = pkh2(acc[0] * g4[0] * sc, acc[1] * g4[1] * sc); o.y = pkh2(acc[2] * g4[2] * sc, acc[3] * g4[3] * sc);
            *(v2u*)(WQ + (size_t)(h * 128 + ct * 16 + fr) * 256 + rt * 16 + 4 * fq) = o;
        }
    }
    {
        const float* w_uv = P.in[13]; const float* w_o = P.in[14]; bf16* WU = (bf16*)(ws + WS_W_UVO);
        const int fr = F.lane & 15, fq = F.lane >> 4;
        for (int strip = F.gw; strip < 1024; strip += F.NGW) {
            const int h = strip >> 7, ct = (strip >> 4) & 7, ns = strip & 15;
            const float* ap = w_uv + (size_t)(ct * 16 + fr) * 1024 + h * 128 + 4 * fq; const float* bp = w_o + (size_t)(h * 128 + 4 * fq) * 1024 + ns * 64 + fr;
            f32x4 acc[4];
#pragma unroll
            for (int t = 0; t < 4; ++t) acc[t] = (f32x4){0.f, 0.f, 0.f, 0.f};
#pragma unroll 2
            for (int sx = 0; sx < 8; ++sx) { const f32x4 av = *(const f32x4*)(ap + 16 * sx); float bvv[4][4];
#pragma unroll
                for (int e = 0; e < 4; ++e)
#pragma unroll
                    for (int t = 0; t < 4; ++t) bvv[e][t] = bp[(size_t)(16 * sx + e) * 1024 + 16 * t];
#pragma unroll
                for (int e = 0; e < 4; ++e)
#pragma unroll
                    for (int t = 0; t < 4; ++t) acc[t] = __builtin_amdgcn_mfma_f32_16x16x4f32(av[e], bvv[e][t], acc[t], 0, 0, 0); }
#pragma unroll
            for (int t = 0; t < 4; ++t) { v2u o; o.x = pk2(acc[t][0], acc[t][1]); o.y = pk2(acc[t][2], acc[t][3]);
                *(v2u*)(WU + (size_t)(ns * 64 + 16 * t + fr) * 1024 + h * 128 + ct * 16 + 4 * fq) = o; }
        }
    }
    for (int i = F.gw * 64 + F.lane; i < 8 * 8 * 128; i += F.NGW * 64) { const int c16 = i & 127, rr = (i >> 7) & 7, pk = i >> 10;
        v4u z; z.x = 0u; z.y = 0u; z.z = 0u; z.w = 0u; *(v4u*)((bf16*)(ws + WS_FLAT) + ((size_t)(pk * 4096 + 4088 + rr) * 1024 + c16 * 8)) = z; }
    {
        const float* rb = P.in[5]; float* BV = (float*)(ws + WS_BIASV);
        for (int i = F.gw * 64 + F.lane; i < 8 * 8192; i += F.NGW * 64) { const int h = i >> 13, dist = i & 8191; const float v = rb[rel_bucket(dist) * 8 + h]; BV[i] = v; BV[65536 + i] = v * 1.4426950408889634f; }
    }
    ph_norm(F, P.in[0], (bf16*)(ws + WS_XN), true);
}

__device__ __forceinline__ void ph_dsa_prep(const Frame& F, const Params& P) {
    unsigned char* ws = P.ws;
    const float* PROJ = (const float*)(ws + WS_PROJ0); bf16* CQ = (bf16*)(ws + WS_CQ); bf16* CKV = (bf16*)(ws + WS_CKV);
    unsigned short* KIDX = (unsigned short*)(ws + WS_KIDX); float* WIDX = (float*)(ws + WS_WIDX);
    const float* gkv = P.in[8]; const float* gk = P.in[9];
    for (int m = F.gw; m < M; m += F.NGW) {
        const float* p = PROJ + (size_t)m * 512; const int lane = F.lane;
        const f32x4 q = *((const f32x4*)p + lane);
        float s = wave_sum((q.x * q.x + q.y * q.y) + (q.z * q.z + q.w * q.w)); float r = 1.0f / sqrtf(s * (1.f / 256) + 1e-6f);
        v2u w; w.x = pkh2(q.x * r, q.y * r); w.y = pkh2(q.z * r, q.w * r); *((v2u*)(CQ + (size_t)m * 256) + lane) = w;
        const f32x2 c = *((const f32x2*)(p + 256) + lane);
        s = wave_sum(c.x * c.x + c.y * c.y); r = 1.0f / sqrtf(s * (1.f / 128) + 1e-6f);
        *((unsigned*)(CKV + (size_t)m * 128) + lane) = pk2(c.x * r * gkv[2 * lane], c.y * r * gkv[2 * lane + 1]);
        const float k = p[384 + lane];
        s = wave_sum(k * k); r = 1.0f / sqrtf(s * (1.f / 64) + 1e-6f);
        KIDX[(size_t)m * 64 + lane] = f2h(k * r * gk[lane]);
        if (lane < 8) WIDX[(size_t)m * 8 + lane] = p[448 + lane] * WIDX_SCALE;
    }
}

__device__ __forceinline__ unsigned f2key(float f) { const unsigned u = __float_as_uint(f); return (u & 0x80000000u) ? ~u : (u | 0x80000000u); }

typedef _Float16 f16x8 __attribute__((ext_vector_type(8)));
typedef float f32x16 __attribute__((ext_vector_type(16)));
constexpr int IX_C = 508, IX_SOFT = 444, IX_CB_OFF = 16384, IX_FLAG = IX_CB_OFF + 64 * IX_C * 4, IX_KB2 = IX_FLAG + 512;

template <int NI> __device__ __forceinline__ void ix_prune8n(LAS unsigned char* lds, const unsigned base0, const int (&cnt)[8], const int minc, const int lowbit, const int lane, unsigned (&tau_out)[8], int (&kept)[8]) {
    unsigned e[8][NI]; unsigned tau[8];
#pragma unroll
    for (int q = 0; q < 8; ++q) { const LAS unsigned* buf = (const LAS unsigned*)(lds + base0 + (unsigned)q * IX_C * 4); tau[q] = 0u;
#pragma unroll
        for (int i = 0; i < NI; ++i) { const int idx = lane + 64 * i; e[q][i] = (cnt[q] > minc && idx < cnt[q]) ? buf[idx] : 0u; } }
    int cacc[8];
#pragma unroll
    for (int q = 0; q < 8; ++q) cacc[q] = cnt[q] > minc ? cnt[q] : 256;
#pragma unroll 1
    for (int bit = 31; bit >= lowbit; --bit) {
        bool alldone = lowbit == 0;
#pragma unroll
        for (int q = 0; q < 8; ++q) { const unsigned cand = tau[q] | (1u << bit); int c = 0;
#pragma unroll
            for (int i = 0; i < NI; ++i) c += __popcll(__ballot(e[q][i] >= cand));
            if (c >= 256) { tau[q] = cand; cacc[q] = c; }
            alldone = alldone && (cacc[q] == 256); }
        if (alldone) break;
    }
#pragma unroll
    for (int q = 0; q < 8; ++q) {
        const unsigned tq = tau[q] ? tau[q] : 1u;
        LAS unsigned* buf = (LAS unsigned*)(lds + base0 + (unsigned)q * IX_C * 4); int run = 0;
#pragma unroll
        for (int i = 0; i < NI; ++i) {
            const bool keep = e[q][i] >= tq; const unsigned long long mk = __ballot(keep);
            const int pre = __builtin_amdgcn_mbcnt_hi((unsigned)(mk >> 32), __builtin_amdgcn_mbcnt_lo((unsigned)mk, 0u));
            if (keep) buf[run + pre] = e[q][i];
            run += __popcll(mk);
        }
        const bool pruned = cnt[q] > minc;
        kept[q] = pruned ? run : cnt[q]; tau_out[q] = (pruned && tau[q] != 0u) ? tau[q] - 1u : 0u;
    }
}

__device__ __forceinline__ void ix_prune8(LAS unsigned char* lds, const unsigned base0, const int (&cnt)[8], const int minc, const int lowbit, const int lane, unsigned (&tau_out)[8], int (&kept)[8]) {
    int mx = 0;
#pragma unroll
    for (int q = 0; q < 8; ++q) mx = cnt[q] > mx ? cnt[q] : mx;
    if (mx <= 448) ix_prune8n<7>(lds, base0, cnt, minc, lowbit, lane, tau_out, kept); else ix_prune8n<8>(lds, base0, cnt, minc, lowbit, lane, tau_out, kept);
}
__device__ __forceinline__ void ph_index_mfma(const Frame& F, const Params& P) {
    unsigned char* ws = P.ws;
    const unsigned short* QIDX = (const unsigned short*)(ws + WS_QIDX); const unsigned short* KIDX = (const unsigned short*)(ws + WS_KIDX);
    const float* WIDX = (const float*)(ws + WS_WIDX); unsigned short* SEL = (unsigned short*)(ws + WS_SEL);
    const int tid = F.tid, lane = F.lane, w = F.wave, hi = lane >> 5, l31 = lane & 31;
    const int a_hr = (l31 >> 2) & 1, a_i = (l31 & 3) + 4 * (l31 >> 3), a_q = 2 * a_hr + (a_i >> 3), a_h = a_i & 7;
    const int st_key = tid >> 3, st_c = tid & 7, st_off = st_key * 128 + ((st_c ^ ((st_key >> 1) & 7)) * 16);
    LAS unsigned* flags = (LAS unsigned*)(F.lds + IX_FLAG);
    for (int p = blockIdx.x; p < 256; p += F.G) {
#pragma unroll 1
        for (int h2 = 0; h2 < 2; ++h2) {
            const int ix = (p >> 3) * 2 + (p & 1), b = (p & 7) >> 1, jt = h2 ? 127 - ix : ix, t0 = jt * 64, m0 = b * T + t0;
            f16x8 AL[4];
            {
                float al[4][8];
#pragma unroll
                for (int ks = 0; ks < 4; ++ks)
#pragma unroll
                    for (int j = 0; j < 8; ++j) al[ks][j] = 0.f;
                if (l31 < 8) {
                    const int lq = 4 * ((l31 & 3) >> 1) + 2 * ((l31 >> 2) & 1) + (l31 & 1);
                    const f32x4* wp = (const f32x4*)(WIDX + (size_t)(m0 + w * 8 + lq) * 8); const f32x4 wx = wp[0], wy = wp[1];
                    const float wq[8] = {wx.x, wx.y, wx.z, wx.w, wy.x, wy.y, wy.z, wy.w};
#pragma unroll
                    for (int hb = 0; hb < 2; ++hb) {
                        f16x8 qv[4][4];
#pragma unroll
                        for (int h4 = 0; h4 < 4; ++h4)
#pragma unroll
                            for (int ks = 0; ks < 4; ++ks) qv[h4][ks] = *(const f16x8*)(QIDX + (size_t)(m0 + w * 8 + lq) * 512 + (4 * hb + h4) * 64 + 16 * ks + 8 * hi);
                        asm volatile("" : "+v"(qv[0][0]), "+v"(qv[0][1]), "+v"(qv[0][2]), "+v"(qv[0][3]), "+v"(qv[1][0]), "+v"(qv[1][1]), "+v"(qv[1][2]), "+v"(qv[1][3]),
                                          "+v"(qv[2][0]), "+v"(qv[2][1]), "+v"(qv[2][2]), "+v"(qv[2][3]), "+v"(qv[3][0]), "+v"(qv[3][1]), "+v"(qv[3][2]), "+v"(qv[3][3]));
#pragma unroll
                        for (int h4 = 0; h4 < 4; ++h4)
#pragma unroll
                            for (int ks = 0; ks < 4; ++ks)
#pragma unroll
                                for (int j = 0; j < 8; ++j) al[ks][j] += wq[4 * hb + h4] * (float)qv[h4][ks][j];
                    }
                }
#pragma unroll
                for (int ks = 0; ks < 4; ++ks)
#pragma unroll
                    for (int j = 0; j < 8; ++j) AL[ks][j] = (_Float16)al[ks][j];
            }
            f16x8 A[2][4]; float wr[2][16];
#pragma unroll
            for (int g = 0; g < 2; ++g) {
#pragma unroll
                for (int ks = 0; ks < 4; ++ks) A[g][ks] = *(const f16x8*)(QIDX + (size_t)(m0 + w * 8 + 4 * g + a_q) * 512 + a_h * 64 + 16 * ks + 8 * hi);
#pragma unroll
                for (int j = 0; j < 2; ++j) { const f32x4* wp = (const f32x4*)(WIDX + (size_t)(m0 + w * 8 + 4 * g + 2 * hi + j) * 8); const f32x4 x = wp[0], y = wp[1];
                    wr[g][8 * j + 0] = x.x; wr[g][8 * j + 1] = x.y; wr[g][8 * j + 2] = x.z; wr[g][8 * j + 3] = x.w; wr[g][8 * j + 4] = y.x; wr[g][8 * j + 5] = y.y; wr[g][8 * j + 6] = y.z; wr[g][8 * j + 7] = y.w; }
            }
            unsigned tauV[4], posV[4], tinv[4];
            unsigned hmask = hi ? 0xFFFFFFFFu : 0u; asm volatile("" : "+v"(hmask));
#pragma unroll
            for (int sl = 0; sl < 4; ++sl) { const int ql = 4 * (sl >> 1) + 2 * hi + (sl & 1); const unsigned base = IX_CB_OFF + (unsigned)(w * 8 + ql) * IX_C * 4;
                tauV[sl] = 0u; posV[sl] = base; tinv[sl] = 8191u - (unsigned)(t0 + w * 8 + ql); }
            const int nch = jt + 1;
            const unsigned short* kbase = KIDX + (size_t)(b * T) * 64 + (size_t)st_key * 64 + st_c * 8;
            v4u kreg = *(const v4u*)kbase;
            { v4u kreg1 = *(const v4u*)(kbase + (size_t)(nch > 1 ? 64 * 64 : 0));
              asm volatile("" : "+v"(kreg), "+v"(kreg1));
              *(LAS v4u*)(F.lds + st_off) = kreg; if (nch > 1) *(LAS v4u*)(F.lds + 8192 + st_off) = kreg1; }
            if (tid < 128) flags[tid] = 0u;
            __syncthreads();
            const unsigned kfr_base = (unsigned)(uintptr_t)F.lds + (unsigned)l31 * 128u, ksw = ((unsigned)l31 >> 1) & 7u;
            const unsigned kfa0 = kfr_base + (((0u + hi) ^ ksw) * 16u), kfa1 = kfr_base + (((2u + hi) ^ ksw) * 16u), kfa2 = kfr_base + (((4u + hi) ^ ksw) * 16u), kfa3 = kfr_base + (((6u + hi) ^ ksw) * 16u);
#define IX_KREAD4(f_, bo_) asm volatile("ds_read_b128 %0, %4\n\tds_read_b128 %1, %5\n\tds_read_b128 %2, %6\n\tds_read_b128 %3, %7" \
                               : "=&v"(f_[0]), "=&v"(f_[1]), "=&v"(f_[2]), "=&v"(f_[3]) : "v"(kfa0 + (bo_)), "v"(kfa1 + (bo_)), "v"(kfa2 + (bo_)), "v"(kfa3 + (bo_)) : "memory")
#define IX_KWAIT4(f_) asm volatile("s_waitcnt lgkmcnt(0)" : "+v"(f_[0]), "+v"(f_[1]), "+v"(f_[2]), "+v"(f_[3]) :: "memory")
            f16x8 kfa[4];
            IX_KREAD4(kfa, 0u); IX_KWAIT4(kfa);
            unsigned o_cur = 0u, o_nxt = 8192u, o_st = (unsigned)IX_KB2;
#pragma unroll 1
            for (int ch = 0; ch < nch; ++ch) {
                if (ch + 2 < nch) kreg = *(const v4u*)(kbase + (size_t)(ch + 2) * 64 * 64);
                const bool lastc = (ch == jt);
                const int ntile = (lastc && (32 > 8 * w + 7)) ? 1 : 2;
                f16x8 kfb[4];
                IX_KREAD4(kfb, o_cur + 4096u);
#pragma unroll
                for (int tile = 0; tile < 2; ++tile) {
                    if (tile >= ntile) break;
                    const int key = tile * 32 + l31;
                    f16x8 kf[4];
#pragma unroll
                    for (int ks = 0; ks < 4; ++ks) kf[ks] = tile == 0 ? kfa[ks] : kfb[ks];
                    const unsigned invidx = 8191u - (unsigned)(64 * ch + key);
                    f32x16 accl, acc2[2];
#pragma unroll
                    for (int i = 0; i < 16; ++i) { accl[i] = 0.f; acc2[0][i] = 0.f; acc2[1][i] = 0.f; }
#pragma unroll
                    for (int ks = 0; ks < 4; ++ks) {
                        accl = __builtin_amdgcn_mfma_f32_32x32x16_f16(AL[ks], kf[ks], accl, 0, 0, 0);
                        acc2[0] = __builtin_amdgcn_mfma_f32_32x32x16_f16(A[0][ks], kf[ks], acc2[0], 0, 0, 0);
                        acc2[1] = __builtin_amdgcn_mfma_f32_32x32x16_f16(A[1][ks], kf[ks], acc2[1], 0, 0, 0);
                    }
                    __builtin_amdgcn_sched_barrier(0);
                    f16x8 nfa[4];
                    if (tile == 0) IX_KWAIT4(kfb);
                    if (tile == 1) IX_KREAD4(nfa, o_nxt);
#pragma unroll
                    for (int g = 0; g < 2; ++g) {
#pragma unroll
                        for (int v = 0; v < 2; ++v) {
                            const int sl = 2 * g + v;
                            float s = accl[sl];
#pragma unroll
                            for (int i = 0; i < 8; ++i) s = __builtin_fmaf(__builtin_fabsf(acc2[g][8 * v + i]), wr[g][8 * v + i], s);
                            unsigned u = __float_as_uint(s); u ^= ((unsigned)((int)u >> 31) | 0x80000000u);
                            unsigned kk = (u & 0xFFFFE000u) | invidx;
                            if (lastc) kk = (invidx >= tinv[sl]) ? kk : 0u;
                            const bool pass = kk > tauV[sl];
                            const unsigned long long mk = __ballot(pass);
                            {
                                const unsigned mlo = (unsigned)mk, mhi = (unsigned)(mk >> 32);
                                const int nlo = __popc(mlo), nhi = __popc(mhi);
                                const unsigned pre = __builtin_amdgcn_mbcnt_hi(mhi, __builtin_amdgcn_mbcnt_lo(mlo, hmask & (unsigned)(-nlo)));
                                if (pass) *(LAS unsigned*)(F.lds + posV[sl] + 4u * pre) = kk;
                                posV[sl] += 4u * (unsigned)nlo + (hmask & (4u * (unsigned)(nhi - nlo)));
                            }
                        }
                    }
                    if (tile == 1) { IX_KWAIT4(nfa);
#pragma unroll
                        for (int ks = 0; ks < 4; ++ks) kfa[ks] = nfa[ks]; }
                }
                {
                    bool ov = false;
#pragma unroll
                    for (int sl = 0; sl < 4; ++sl) { const int ql = 4 * (sl >> 1) + 2 * hi + (sl & 1); ov |= posV[sl] > IX_CB_OFF + (unsigned)(w * 8 + ql) * IX_C * 4 + IX_SOFT * 4; }
                    if (__ballot(ov) != 0ull && lane == 0) flags[ch] = 1u;
                }
                if (ch + 2 < nch) *(LAS v4u*)(F.lds + o_st + st_off) = kreg;
                { const unsigned o_t = o_cur; o_cur = o_nxt; o_nxt = o_st; o_st = o_t; }
                __syncthreads();
                if (flags[ch] != 0u) {
                    int cntq[8]; unsigned tq8[8]; int kq[8];
#pragma unroll
                    for (int sl = 0; sl < 4; ++sl)
#pragma unroll
                        for (int hf = 0; hf < 2; ++hf) { const int ql = 4 * (sl >> 1) + 2 * hf + (sl & 1);
                            cntq[ql] = (int)((unsigned)__builtin_amdgcn_readlane((int)posV[sl], 32 * hf) - (IX_CB_OFF + (unsigned)(w * 8 + ql) * IX_C * 4)) >> 2; }
                    ix_prune8(F.lds, IX_CB_OFF + (unsigned)(w * 8) * IX_C * 4, cntq, 288, 17, lane, tq8, kq);
                    { bool big = false;
#pragma unroll
                      for (int q = 0; q < 8; ++q) big |= (cntq[q] > 288) && (kq[q] > 400);
                      if (big) { int c2[8]; unsigned t2[8]; int k2[8];
#pragma unroll
                          for (int q = 0; q < 8; ++q) c2[q] = cntq[q] > 288 ? kq[q] : 0;
                          ix_prune8(F.lds, IX_CB_OFF + (unsigned)(w * 8) * IX_C * 4, c2, 288, 0, lane, t2, k2);
#pragma unroll
                          for (int q = 0; q < 8; ++q) if (c2[q] > 288) { tq8[q] = t2[q]; kq[q] = k2[q]; } } }
#pragma unroll
                    for (int sl = 0; sl < 4; ++sl)
#pragma unroll
                        for (int hf = 0; hf < 2; ++hf) { const int ql = 4 * (sl >> 1) + 2 * hf + (sl & 1);
                            if (cntq[ql] > 288 && hi == hf) { tauV[sl] = tq8[ql]; posV[sl] = IX_CB_OFF + (unsigned)(w * 8 + ql) * IX_C * 4 + 4u * (unsigned)kq[ql]; } }
                }
            }
            {
                int cntq[8]; unsigned tq8[8]; int kq[8];
#pragma unroll
                for (int sl = 0; sl < 4; ++sl)
#pragma unroll
                    for (int hf = 0; hf < 2; ++hf) { const int ql = 4 * (sl >> 1) + 2 * hf + (sl & 1);
                        cntq[ql] = (int)((unsigned)__builtin_amdgcn_readlane((int)posV[sl], 32 * hf) - (IX_CB_OFF + (unsigned)(w * 8 + ql) * IX_C * 4)) >> 2; }
                ix_prune8(F.lds, IX_CB_OFF + (unsigned)(w * 8) * IX_C * 4, cntq, 256, 0, lane, tq8, kq);
#pragma unroll
                for (int ql = 0; ql < 8; ++ql) {
                    const LAS unsigned* buf = (const LAS unsigned*)(F.lds + IX_CB_OFF + (unsigned)(w * 8 + ql) * IX_C * 4);
                    const int cnt = kq[ql];
                    unsigned short* out = SEL + (size_t)(m0 + w * 8 + ql) * 256;
                    unsigned bv[4];
#pragma unroll
                    for (int i = 0; i < 4; ++i) bv[i] = buf[lane + 64 * i];
                    asm volatile("" : "+v"(bv[0]), "+v"(bv[1]), "+v"(bv[2]), "+v"(bv[3]));
#pragma unroll
                    for (int i = 0; i < 4; ++i) { const int idx = lane + 64 * i; out[idx] = idx < cnt ? (unsigned short)(8191u - (bv[i] & 0x1FFFu)) : (unsigned short)0xFFFF; }
                }
            }
            __syncthreads();
        }
    }
}

__device__ __forceinline__ void ph_cmp_gather(const Frame& F, const Params& P) {
    unsigned char* ws = P.ws; const bf16* KV = (const bf16*)(ws + WS_KV); bf16* FLAT = (bf16*)(ws + WS_FLAT);
    const int NIT = 2 * 4096 * 16;
    for (int it = F.gw; it < NIT; it += F.NGW) {
        const int jp = it & 15, row = (it >> 4) & 4095, part = it >> 16;
        const int j = jp * 2 + (F.lane >> 5), d = (F.lane & 31) * 4;
        const int k = j * 128 + d, ks = k >> 10, kk = k & 1023;
        v2u o; o.x = 0u; o.y = 0u;
        if (row < 4088) {
            const int g = row & 1, bn = row >> 1, n = bn % NCMP, b = bn / NCMP;
            const v2u w = *(const v2u*)(KV + (size_t)(b * T + 16 * n + j) * KVW + part * 256 + g * 128 + d);
            const f32x4 pp = *(const f32x4*)(P.in[part ? 18 : 17] + j * 128 + d);
            o.x = pk2(bflo(w.x) + pp.x, bfhi(w.x) + pp.y); o.y = pk2(bflo(w.y) + pp.z, bfhi(w.y) + pp.w);
        }
        *(v2u*)(FLAT + (((size_t)(part * 4 + ks) * 4096 + row) * 1024 + kk)) = o;
    }
}
struct CmpOrder {
    int G, c;
    __device__ bool next(int i, pg8::Unit& u) const { const int L = i * G + c; if (L >= 128) return false; u.pm = L; u.pn = L >> 4; return true; }
    __device__ __forceinline__ void a_ready(const pg8::Unit&) const {}
    __device__ __forceinline__ void done(const pg8::Unit&) const {}
};
struct GateOrder {
    int G, c;
    __device__ bool next(int i, pg8::Unit& u) const { const int i0 = c >= 128 ? 0 : (128 - c + G - 1) / G; const int L = (i0 + i) * G + c; if (L >= 256) return false; u.pm = L - 128; u.pn = 0; return true; }
    __device__ __forceinline__ void a_ready(const pg8::Unit&) const {}
    __device__ __forceinline__ void done(const pg8::Unit&) const {}
};
__device__ __forceinline__ void ph_cmp_reduce(const Frame& F, const Params& P) {
    unsigned char* ws = P.ws; const float* PART = (const float*)(ws + WS_PART);
    LAS float* w2s = (LAS float*)F.lds;
    const int half = F.G / 2;
    for (int pc = blockIdx.x; pc < 2 * half; pc += F.G) {
        const int part = pc >= half ? 1 : 0, wgi = part ? pc - half : pc;
        const float* w2 = P.in[part ? 22 : 20]; bf16* OUT = (bf16*)(ws + (part ? WS_VC : WS_KC));
        __syncthreads();
        {
            f32x4 tw[16];
#pragma unroll
            for (int k = 0; k < 16; ++k) tw[k] = ((const f32x4*)w2)[F.tid + NTHR * k];
#pragma unroll
            for (int k = 0; k < 16; ++k) ((LAS f32x4*)w2s)[F.tid + NTHR * k] = tw[k];
        }
        __syncthreads();
        const int rstep = half * NWAVES;
        for (int row0 = wgi * NWAVES + F.wave; row0 < 4096; row0 += 4 * rstep) {
            float hv[4][4]; bool live[4];
            f32x4 pv[4][4];
#pragma unroll
            for (int k = 0; k < 4; ++k) { const int row = row0 + k * rstep, rowc = row < 4088 ? row : 4087;
#pragma unroll
                for (int ks = 0; ks < 4; ++ks) pv[k][ks] = *((const f32x4*)(PART + ((size_t)(part * 4 + ks) * 4096 + rowc) * 256) + F.lane); }
#pragma unroll
            for (int k = 0; k < 4; ++k) asm volatile("" : "+v"(pv[k][0]), "+v"(pv[k][1]), "+v"(pv[k][2]), "+v"(pv[k][3]));
#pragma unroll
            for (int k = 0; k < 4; ++k) { const int row = row0 + k * rstep; live[k] = row < 4088;
                f32x4 sacc = (pv[k][0] + pv[k][1]) + (pv[k][2] + pv[k][3]);
                if (!live[k]) sacc = (f32x4){0.f, 0.f, 0.f, 0.f};
#pragma unroll
                for (int e = 0; e < 4; ++e) { const float v = sacc[e]; const float u = 0.7978845608028654f * (v + 0.044715f * v * v * v); hv[k][e] = 0.5f * v * (1.0f + tanhf(u)); } }
            float acc[4][2];
#pragma unroll
            for (int k = 0; k < 4; ++k) { acc[k][0] = 0.f; acc[k][1] = 0.f; }
#pragma unroll 2
            for (int l = 0; l < 64; ++l) {
#pragma unroll
                for (int e = 0; e < 4; ++e) { const f32x2 wv = *((const LAS f32x2*)(w2s + (4 * l + e) * 128) + F.lane);
#pragma unroll
                    for (int k = 0; k < 4; ++k) { const float hj = __builtin_bit_cast(float, __builtin_amdgcn_readlane(__builtin_bit_cast(int, hv[k][e]), l)); acc[k][0] += hj * wv.x; acc[k][1] += hj * wv.y; } } }
#pragma unroll
            for (int k = 0; k < 4; ++k) { const int row = row0 + k * rstep;
                if (row < 4096) {
                    if (row >= 4088) {
                        const int pr = row - 4088, pb = pr >> 1, pg = pr & 1; *((unsigned*)(OUT + ((size_t)(pb * 512 + 511) * 2 + pg) * 128) + F.lane) = 0u; }
                    else { const int orow_ = ((row >> 1) / NCMP * 512 + (row >> 1) % NCMP) * 2 + (row & 1); *((unsigned*)(OUT + (size_t)orow_ * 128) + F.lane) = pk2(acc[k][0], acc[k][1]); } } }
        }
    }
}

typedef short bf16x8v __attribute__((ext_vector_type(8)));
typedef short s16x4v __attribute__((ext_vector_type(4)));
typedef __bf16 bf16x2_t __attribute__((ext_vector_type(2)));
constexpr float LOG2E = 1.4426950408889634f;
constexpr float NS_FLOOR = -10000.f;
constexpr int NS_K = 0, NS_V = 49152, NS_T = 98304, NS_TBUF = 2304, NS_TROW = 544, NS_NEG = 98304 + 3 * NS_TBUF, NS_IMP = 106496, NS_IMPROW = 132, NS_WM = NS_IMP + 8 * 8 * NS_IMPROW * 4, NS_GATE = NS_WM + 128 + 1024;
__device__ __forceinline__ unsigned cvtpk(float lo, float hi) { const f32x2 v = {lo, hi}; const bf16x2_t b = __builtin_convertvector(v, bf16x2_t); return __builtin_bit_cast(unsigned, b); }
__device__ __forceinline__ float swap32_max(float m) { const auto rr = __builtin_amdgcn_permlane32_swap(__float_as_uint(m), __float_as_uint(m), false, false); return fmaxf(__uint_as_float(rr[0]), __uint_as_float(rr[1])); }
__device__ __forceinline__ float swap32_sum(float m) { const auto rr = __builtin_amdgcn_permlane32_swap(__float_as_uint(m), __float_as_uint(m), false, false); return __uint_as_float(rr[0]) + __uint_as_float(rr[1]); }
__device__ __forceinline__ float quad_sum(float x) {
    x += __builtin_bit_cast(float, __builtin_amdgcn_update_dpp(0, __builtin_bit_cast(int, x), 0xB1, 0xF, 0xF, false));
    x += __builtin_bit_cast(float, __builtin_amdgcn_update_dpp(0, __builtin_bit_cast(int, x), 0x4E, 0xF, 0xF, false));
    return x;
}
__device__ __forceinline__ bf16x8v ns_vfrag(const LAS unsigned char* p0, const LAS unsigned char* p1) {
    const s16x4v lo = __builtin_bit_cast(s16x4v, __builtin_amdgcn_ds_read_tr16_b64_v4i16((LAS s16x4v*)p0));
    const s16x4v hi = __builtin_bit_cast(s16x4v, __builtin_amdgcn_ds_read_tr16_b64_v4i16((LAS s16x4v*)p1));
    return (bf16x8v){lo[0], lo[1], lo[2], lo[3], hi[0], hi[1], hi[2], hi[3]};
}
__device__ __forceinline__ float max3f(float a, float b, float c) { float r; asm("v_max3_f32 %0, %1, %2, %3" : "=v"(r) : "v"(a), "v"(b), "v"(c)); return r; }
__device__ __forceinline__ float max16f(const f32x16& S) {
    float r;
    asm volatile("v_max3_f32 %0, %1, %2, %3\n\tv_max3_f32 %0, %0, %4, %5\n\tv_max3_f32 %0, %0, %6, %7\n\tv_max3_f32 %0, %0, %8, %9\n\t"
        "v_max3_f32 %0, %0, %10, %11\n\tv_max3_f32 %0, %0, %12, %13\n\tv_max3_f32 %0, %0, %14, %15\n\tv_max_f32 %0, %0, %16"
        : "=&v"(r) : "v"(S[0]), "v"(S[1]), "v"(S[2]), "v"(S[3]), "v"(S[4]), "v"(S[5]), "v"(S[6]), "v"(S[7]), "v"(S[8]), "v"(S[9]), "v"(S[10]), "v"(S[11]), "v"(S[12]), "v"(S[13]), "v"(S[14]), "v"(S[15]));
    return r;
}
__device__ __forceinline__ void lds_rd4_b128(bf16x8v (&f)[4], const unsigned a0, const unsigned a1) {
    asm volatile("ds_read_b128 %0, %4\n\tds_read_b128 %1, %4 offset:8192\n\tds_read_b128 %2, %5\n\tds_read_b128 %3, %5 offset:8192"
                 : "=&v"(f[0]), "=&v"(f[1]), "=&v"(f[2]), "=&v"(f[3]) : "v"(a0), "v"(a1) : "memory");
}
template <int N> __device__ __forceinline__ void lds_wait4(bf16x8v (&f)[4]) { asm volatile("s_waitcnt lgkmcnt(%4)" : "+v"(f[0]), "+v"(f[1]), "+v"(f[2]), "+v"(f[3]) : "n"(N) : "memory"); }
template <int OFF> __device__ __forceinline__ void lds_rdtr4(v2u (&lo)[4], v2u (&hi)[4], const unsigned (&va)[4][2]) {
    asm volatile("ds_read_b64_tr_b16 %0, %8 offset:%16\n\tds_read_b64_tr_b16 %1, %9 offset:%16\n\tds_read_b64_tr_b16 %2, %10 offset:%16\n\tds_read_b64_tr_b16 %3, %11 offset:%16\n\t"
                 "ds_read_b64_tr_b16 %4, %12 offset:%16\n\tds_read_b64_tr_b16 %5, %13 offset:%16\n\tds_read_b64_tr_b16 %6, %14 offset:%16\n\tds_read_b64_tr_b16 %7, %15 offset:%16"
                 : "=&v"(lo[0]), "=&v"(hi[0]), "=&v"(lo[1]), "=&v"(hi[1]), "=&v"(lo[2]), "=&v"(hi[2]), "=&v"(lo[3]), "=&v"(hi[3])
                 : "v"(va[0][0]), "v"(va[0][1]), "v"(va[1][0]), "v"(va[1][1]), "v"(va[2][0]), "v"(va[2][1]), "v"(va[3][0]), "v"(va[3][1]), "n"(OFF) : "memory");
}
template <int N> __device__ __forceinline__ void lds_wait8(v2u (&lo)[4], v2u (&hi)[4]) {
    asm volatile("s_waitcnt lgkmcnt(%8)" : "+v"(lo[0]), "+v"(hi[0]), "+v"(lo[1]), "+v"(hi[1]), "+v"(lo[2]), "+v"(hi[2]), "+v"(lo[3]), "+v"(hi[3]) : "n"(N) : "memory");
}
__device__ __forceinline__ bf16x8v vcat(const v2u lo, const v2u hi) { v4u t; t.x = lo.x; t.y = lo.y; t.z = hi.x; t.w = hi.y; return __builtin_bit_cast(bf16x8v, t); }
template <int MODE, int COFS>
__device__ __forceinline__ void ns_half(f32x16& S, const unsigned (&va)[4][2], const float sub, float& l_run, f32x16 (&O)[4], const float inv_l, LAS float* improw, const int jblk, const int r) {
    v2u vlo0[4], vhi0[4], vlo1[4], vhi1[4];
    if (MODE == 2) { lds_rdtr4<4096 * (COFS >> 4)>(vlo0, vhi0, va); lds_rdtr4<4096 * (COFS >> 4) + 4096>(vlo1, vhi1, va); }
    if (MODE != 1) {
        f32x2 ls2 = {0.f, 0.f};
#pragma unroll
        for (int i = 0; i < 16; i += 2) { S[i] = __builtin_amdgcn_exp2f(S[i] - sub); S[i + 1] = __builtin_amdgcn_exp2f(S[i + 1] - sub); ls2 += (f32x2){S[i], S[i + 1]}; }
        l_run += ls2.x + ls2.y;
    } else {
#pragma unroll
        for (int i = 0; i < 16; ++i) S[i] = __builtin_amdgcn_exp2f(S[i] - sub) * inv_l;
#pragma unroll
        for (int a = 0; a < 4; ++a) {
            const float mainv = quad_sum((S[4 * a] + S[4 * a + 1]) + (S[4 * a + 2] + 0.5f * S[4 * a + 3])), sidev = quad_sum(0.5f * S[4 * a + 3]);
            if (r == 0) { LAS float* ip = improw + jblk + 2 * a;
                __hip_atomic_fetch_add(ip, mainv, __ATOMIC_RELAXED, __HIP_MEMORY_SCOPE_WORKGROUP); __hip_atomic_fetch_add(ip + 1, sidev, __ATOMIC_RELAXED, __HIP_MEMORY_SCOPE_WORKGROUP); }
        }
    }
    if (MODE == 0) return;
    v4u pw0, pw1;
    pw0.x = cvtpk(S[0], S[1]); pw0.y = cvtpk(S[2], S[3]); pw0.z = cvtpk(S[4], S[5]); pw0.w = cvtpk(S[6], S[7]);
    pw1.x = cvtpk(S[8], S[9]); pw1.y = cvtpk(S[10], S[11]); pw1.z = cvtpk(S[12], S[13]); pw1.w = cvtpk(S[14], S[15]);
    const bf16x8v pf0 = __builtin_bit_cast(bf16x8v, pw0), pf1 = __builtin_bit_cast(bf16x8v, pw1);
    if (MODE == 1) { lds_rdtr4<4096 * (COFS >> 4)>(vlo0, vhi0, va); lds_rdtr4<4096 * (COFS >> 4) + 4096>(vlo1, vhi1, va); }
    lds_wait8<8>(vlo0, vhi0);
#pragma unroll
    for (int ct = 0; ct < 4; ++ct) O[ct] = __builtin_amdgcn_mfma_f32_32x32x16_bf16(vcat(vlo0[ct], vhi0[ct]), pf0, O[ct], 0, 0, 0);
    lds_wait8<0>(vlo1, vhi1);
#pragma unroll
    for (int ct = 0; ct < 4; ++ct) O[ct] = __builtin_amdgcn_mfma_f32_32x32x16_bf16(vcat(vlo1[ct], vhi1[ct]), pf1, O[ct], 0, 0, 0);
}
template <int MODE>
__device__ __forceinline__ void ns_tile(LAS unsigned char* lds, const int kb, const int vb, const unsigned tbase, const bool constb, const bf16x8v (&Qf)[8], const unsigned kbase0, const unsigned vbase0,
                                        const bool edge, const int bl, const int bh, float& m_run, float& l_run, f32x16 (&O)[4], const float inv_l, LAS float* improw, const int jblk0, const int r,
                                        const float cb = 0.f, const bool dead = false) {
    f32x16 S0, S1;
    const unsigned ldsb = (unsigned)(uintptr_t)lds;
    const unsigned kt = ldsb + (unsigned)kb;
    if (MODE == 2 && !constb) { const LAS float* Tl = (const LAS float*)(lds + tbase);
#pragma unroll
        for (int i = 0; i < 16; ++i) { S0[i] = Tl[(i & 3) + 8 * (i >> 2)]; S1[i] = Tl[(i & 3) + 8 * (i >> 2) + 32]; }
    } else {
#pragma unroll
        for (int i = 0; i < 16; ++i) { S0[i] = 0.f; S1[i] = 0.f; }
    }
    bf16x8v fa[4], fb[4];
    lds_rd4_b128(fa, kt + kbase0, kt + (kbase0 ^ 32u));
    lds_rd4_b128(fb, kt + (kbase0 ^ 64u), kt + (kbase0 ^ 96u));
    lds_wait4<4>(fa);
    S0 = __builtin_amdgcn_mfma_f32_32x32x16_bf16(fa[0], Qf[0], S0, 0, 0, 0); S1 = __builtin_amdgcn_mfma_f32_32x32x16_bf16(fa[1], Qf[0], S1, 0, 0, 0);
    S0 = __builtin_amdgcn_mfma_f32_32x32x16_bf16(fa[2], Qf[1], S0, 0, 0, 0); S1 = __builtin_amdgcn_mfma_f32_32x32x16_bf16(fa[3], Qf[1], S1, 0, 0, 0);
    __builtin_amdgcn_sched_barrier(0);
    lds_rd4_b128(fa, kt + (kbase0 ^ 128u), kt + (kbase0 ^ 160u));
    lds_wait4<4>(fb);
    S0 = __builtin_amdgcn_mfma_f32_32x32x16_bf16(fb[0], Qf[2], S0, 0, 0, 0); S1 = __builtin_amdgcn_mfma_f32_32x32x16_bf16(fb[1], Qf[2], S1, 0, 0, 0);
    S0 = __builtin_amdgcn_mfma_f32_32x32x16_bf16(fb[2], Qf[3], S0, 0, 0, 0); S1 = __builtin_amdgcn_mfma_f32_32x32x16_bf16(fb[3], Qf[3], S1, 0, 0, 0);
    __builtin_amdgcn_sched_barrier(0);
    lds_rd4_b128(fb, kt + (kbase0 ^ 192u), kt + (kbase0 ^ 224u));
    lds_wait4<4>(fa);
    S0 = __builtin_amdgcn_mfma_f32_32x32x16_bf16(fa[0], Qf[4], S0, 0, 0, 0); S1 = __builtin_amdgcn_mfma_f32_32x32x16_bf16(fa[1], Qf[4], S1, 0, 0, 0);
    S0 = __builtin_amdgcn_mfma_f32_32x32x16_bf16(fa[2], Qf[5], S0, 0, 0, 0); S1 = __builtin_amdgcn_mfma_f32_32x32x16_bf16(fa[3], Qf[5], S1, 0, 0, 0);
    __builtin_amdgcn_sched_barrier(0);
    unsigned va[4][2];
    { const unsigned vt = ldsb + (unsigned)vb;
#pragma unroll
      for (int ct = 0; ct < 4; ++ct) { va[ct][0] = vt + (vbase0 ^ (64u * ct)); va[ct][1] = vt + ((vbase0 ^ (64u * ct)) ^ 2080u); } }
    lds_wait4<0>(fb);
    S0 = __builtin_amdgcn_mfma_f32_32x32x16_bf16(fb[0], Qf[6], S0, 0, 0, 0); S1 = __builtin_amdgcn_mfma_f32_32x32x16_bf16(fb[1], Qf[6], S1, 0, 0, 0);
    S0 = __builtin_amdgcn_mfma_f32_32x32x16_bf16(fb[2], Qf[7], S0, 0, 0, 0); S1 = __builtin_amdgcn_mfma_f32_32x32x16_bf16(fb[3], Qf[7], S1, 0, 0, 0);
    __builtin_amdgcn_sched_barrier(0);
    if (edge) {
#pragma unroll
        for (int i = 0; i < 16; ++i) { const int c0 = (i & 3) + 8 * (i >> 2), c1 = c0 + 32;
            S0[i] = (c0 >= bl && c0 <= bh) ? S0[i] : NEGF; S1[i] = (c1 >= bl && c1 <= bh) ? S1[i] : NEGF; }
    }
    float sub = m_run;
    if (MODE != 1) {
        if (!edge) asm volatile("s_nop 7\n\ts_nop 7" ::: );
        float mx; { const float ma = max16f(S0), mb = max16f(S1); asm("v_max_f32 %0, %1, %2" : "=v"(mx) : "v"(ma), "v"(mb)); }
        mx = swap32_max(mx) + cb;
        if (__ballot(!dead && (mx > m_run + 60.f)) != 0ull) {
            const float m_new = dead ? m_run : fmaxf(m_run, mx);
            const float sc = __builtin_amdgcn_exp2f(m_run - m_new); l_run *= sc;
            if (MODE == 2) {
#pragma unroll
                for (int ct = 0; ct < 4; ++ct)
#pragma unroll
                    for (int i = 0; i < 16; ++i) O[ct][i] *= sc;
            }
            m_run = m_new;
        }
        sub = dead ? 1e30f : (m_run - cb);
    }
    ns_half<MODE, 0>(S0, va, sub, l_run, O, inv_l, improw, jblk0, r);
    ns_half<MODE, 32>(S1, va, sub, l_run, O, inv_l, improw, jblk0 + 8, r);
}
__device__ __forceinline__ void ns_emit(bf16* orow, const f32x16 (&O)[4], const float scale, const int hi, const bool accumulate) {
#pragma unroll
    for (int ct = 0; ct < 4; ++ct)
#pragma unroll
        for (int a = 0; a < 4; ++a) {
            v2u* p = (v2u*)(orow + 32 * ct + 8 * a + 4 * hi);
            float x0 = O[ct][4 * a] * scale, x1 = O[ct][4 * a + 1] * scale, x2 = O[ct][4 * a + 2] * scale, x3 = O[ct][4 * a + 3] * scale;
            if (accumulate) { const v2u old = *p; x0 += bflo(old.x); x1 += bfhi(old.x); x2 += bflo(old.y); x3 += bfhi(old.y); }
            v2u o; o.x = cvtpk(x0, x1); o.y = cvtpk(x2, x3); *p = o;
        }
}
__device__ __forceinline__ void ns_emit_rows(LAS unsigned char* lds, const int w, const int b0, const int b1, bf16* obase, const f32x16 (&O)[4], const float scale, const int lane, const bool accumulate) {
    const int l31 = lane & 31, hi = lane >> 5;
#define NS_PIECE(R_) ((unsigned)(NS_K + ((R_) >> 4) * (NS_V - NS_K) + ((((R_) >> 3) & 1) ? b1 : b0) * 16384 + w * 2048 + ((R_) & 7) * 256))
    { LAS unsigned char* wrow = lds + NS_PIECE(l31) + hi * 8; const unsigned sw = (unsigned)(l31 & 15);
#pragma unroll
      for (int ct = 0; ct < 4; ++ct)
#pragma unroll
          for (int a = 0; a < 4; ++a) { v2u o; o.x = cvtpk(O[ct][4 * a] * scale, O[ct][4 * a + 1] * scale); o.y = cvtpk(O[ct][4 * a + 2] * scale, O[ct][4 * a + 3] * scale);
              *(LAS v2u*)(wrow + (((unsigned)(4 * ct + a) ^ sw) << 4)) = o; } }
    LDS_WAIT(); asm volatile("" ::: "memory");
    const int j = lane & 15;
    v4u nw[8], od[8];
#pragma unroll
    for (int k = 0; k < 8; ++k) { const int R = 4 * k + (lane >> 4);
        nw[k] = *(const LAS v4u*)(lds + NS_PIECE(R) + (((unsigned)j ^ (unsigned)(R & 15)) << 4));
        if (accumulate) od[k] = *(const v4u*)(obase + (size_t)(R >> 2) * 1024 + (R & 3) * 128 + 8 * j); }
#pragma unroll
    for (int k = 0; k < 8; ++k) { const int R = 4 * k + (lane >> 4); v4u o = nw[k];
        if (accumulate) {
            o.x = cvtpk(bflo(nw[k].x) + bflo(od[k].x), bfhi(nw[k].x) + bfhi(od[k].x)); o.y = cvtpk(bflo(nw[k].y) + bflo(od[k].y), bfhi(nw[k].y) + bfhi(od[k].y));
            o.z = cvtpk(bflo(nw[k].z) + bflo(od[k].z), bfhi(nw[k].z) + bfhi(od[k].z)); o.w = cvtpk(bflo(nw[k].w) + bflo(od[k].w), bfhi(nw[k].w) + bfhi(od[k].w)); }
        *(v4u*)(obase + (size_t)(R >> 2) * 1024 + (R & 3) * 128 + 8 * j) = o; }
#undef NS_PIECE
}
__device__ __forceinline__ int ns_next_bit(const unsigned m0, const unsigned m1, const unsigned m2, const unsigned m3, const int from) {
    if (from >= 128) return 128;
    const int wd = from >> 5; const unsigned lowm = 0xFFFFFFFFu << (from & 31);
    unsigned x;
    x = (wd == 0) ? (m0 & lowm) : 0u; if (x) return __builtin_ctz(x);
    x = (wd == 1) ? (m1 & lowm) : (wd < 1 ? m1 : 0u); if (x) return 32 + __builtin_ctz(x);
    x = (wd == 2) ? (m2 & lowm) : (wd < 2 ? m2 : 0u); if (x) return 64 + __builtin_ctz(x);
    x = (wd == 3) ? (m3 & lowm) : m3; if (x) return 96 + __builtin_ctz(x);
    return 128;
}

__device__ __forceinline__ void ph_nsa_attn_flash(const Frame& F, const Params& P) {
    unsigned char* ws = P.ws;
    const bf16* QN = (const bf16*)(ws + WS_QN); const bf16* KV = (const bf16*)(ws + WS_KV); const bf16* KC = (const bf16*)(ws + WS_KC); const bf16* VC = (const bf16*)(ws + WS_VC);
    const float* GATES = (const float*)(ws + WS_GATES); const float* BV = (const float*)(ws + WS_BIASV); bf16* ONSA = (bf16*)(ws + WS_XN);
    LAS unsigned char* lds = F.lds;
    const int tid = F.tid, lane = F.lane, w = F.wave, hi = lane >> 5, l31 = lane & 31, qi = l31 >> 2, r = l31 & 3, qoff = w * 8 + qi;
    for (int i = tid; i < 256; i += NTHR) ((LAS float*)(lds + NS_NEG))[i] = NEGF;
    LAS float* improw = (LAS float*)(lds + NS_IMP) + (w * 8 + qi) * NS_IMPROW;
#define NS_OFF(i_, stride_) ((8u * w + 4u * (i_) + ((unsigned)lane >> 4)) * (stride_) + ((((unsigned)lane & 15u) ^ ((((unsigned)lane >> 4) << 2) | ((2u * w + (i_)) & 3u))) * 8u))
#define okv0 NS_OFF(0u, (unsigned)KVW)
#define okv1 NS_OFF(1u, (unsigned)KVW)
#define oc0 NS_OFF(0u, 256u)
#define oc1 NS_OFF(1u, 256u)
    const float* BV2 = BV + 65536;
#define NS_DMA_KV(kp, vp, o0, o1, buf) do { \
        __builtin_amdgcn_global_load_lds((const unsigned*)((kp) + (o0)), (LAS unsigned*)(lds + NS_K + (buf) * 16384 + w * 2048), 16, 0, 0); \
        __builtin_amdgcn_global_load_lds((const unsigned*)((kp) + (o1)), (LAS unsigned*)(lds + NS_K + (buf) * 16384 + w * 2048 + 1024), 16, 0, 0); \
        __builtin_amdgcn_global_load_lds((const unsigned*)((vp) + (o0)), (LAS unsigned*)(lds + NS_V + (buf) * 16384 + w * 2048), 16, 0, 0); \
        __builtin_amdgcn_global_load_lds((const unsigned*)((vp) + (o1)), (LAS unsigned*)(lds + NS_V + (buf) * 16384 + w * 2048 + 1024), 16, 0, 0); } while (0)
#define NS_DMA_T(js, buf) do { int dist_ = 64 * (jt - (js)) + 63 - (64 * (w & 1) + lane); dist_ = dist_ < 0 ? 0 : dist_; \
        __builtin_amdgcn_global_load_lds((const unsigned*)(BV2 + (g * 4 + (w >> 1)) * 8192 + dist_), (LAS unsigned*)(lds + NS_T + (buf) * NS_TBUF + (w >> 1) * NS_TROW + (w & 1) * 256), 4, 0, 0); } while (0)
#define NS_WAIT_SYNC(more, ops) do { if (more) { if ((ops) == 5) asm volatile("s_waitcnt vmcnt(5)" ::: "memory"); else asm volatile("s_waitcnt vmcnt(4)" ::: "memory"); } \
                                     else asm volatile("s_waitcnt vmcnt(0)" ::: "memory"); __syncthreads(); } while (0)
#define NS_LANE_SETUP() \
    const int lane = lane_id_asm(); const int hi = lane >> 5, l31 = lane & 31, qi = l31 >> 2, r = l31 & 3, qoff = w * 8 + qi; \
    const unsigned kof0 = 256u * l31 + 16u * ((unsigned)hi ^ ((((unsigned)l31 & 3) << 2) | (((unsigned)l31 >> 2) & 3))); \
    const unsigned vof0 = 256u * (4 * hi + (((unsigned)lane & 15) >> 2)) + 8u * ((unsigned)lane & 1) + 64u * (((unsigned)lane & 15) >> 2) + 16u * ((2 * (((unsigned)lane >> 4) & 1) + (((unsigned)lane & 3) >> 1)) ^ (unsigned)hi); \
    LAS float* improw = (LAS float*)(lds + NS_IMP) + (w * 8 + qi) * NS_IMPROW; (void)improw; \
    bf16* orow = ONSA + (size_t)(m0 + qoff) * 1024 + (g * 4 + r) * 128; (void)orow; (void)kof0; (void)vof0; \
    const unsigned okvA = NS_OFF(0u, (unsigned)KVW), okvB = NS_OFF(1u, (unsigned)KVW); (void)okvA; (void)okvB;
    for (int c = blockIdx.x; c < 256; c += F.G) {
#pragma unroll 1
        for (int u4 = 0; u4 < 4; ++u4) {
            const int xq = c & 7, iq = c >> 3, b = xq >> 1, g = xq & 1, jt = u4 == 0 ? iq : (u4 == 1 ? 63 - iq : (u4 == 2 ? 64 + iq : 127 - iq)), t0 = jt * 64, m0 = b * T + t0;
            bf16x8v Qf[8];
#pragma unroll
            for (int ks = 0; ks < 8; ++ks) Qf[ks] = *(const bf16x8v*)(QN + (size_t)(m0 + qoff) * 1024 + (g * 4 + r) * 128 + 16 * ks + 8 * hi);
            LAS float* gl = (LAS float*)(lds + NS_GATE) + (w * 32 + l31) * 4;
            if (hi == 0) { const float* gp0 = GATES + (size_t)(m0 + qoff) * 24 + (g * 4 + r) * 3; const float ga = gp0[0], gb = gp0[1], gc = gp0[2]; gl[0] = ga; gl[1] = gb; gl[2] = gc; }
#define gate0 (((const LAS float*)(lds + NS_GATE) + (w * 32 + (lane & 31)) * 4)[0])
#define gate1 (((const LAS float*)(lds + NS_GATE) + (w * 32 + (lane & 31)) * 4)[1])
#define gate2 (((const LAS float*)(lds + NS_GATE) + (w * 32 + (lane & 31)) * 4)[2])
            bf16* orow = ONSA + (size_t)(m0 + qoff) * 1024 + (g * 4 + r) * 128;
            f32x16 O[4]; float m_run, l_run;
            const int ntl = (((t0 + 32) >> 4) >> 6) + 1;
            const bf16* kcb = KC + ((size_t)(b * 512) * 2 + g) * 128; const bf16* vcb = VC + ((size_t)(b * 512) * 2 + g) * 128;
            for (int i = lane; i < 8 * NS_IMPROW; i += 64) ((LAS float*)(lds + NS_IMP))[w * 8 * NS_IMPROW + i] = 0.f;
            float m_fin = 0.f, inv_l = 0.f;
#ifndef NS_SKIP_CMP
            { NS_LANE_SETUP();
            const int tq = t0 + qoff; const int nlim = tq >= 31 ? ((tq - 31) >> 4) : -1;
            {
                m_run = 0.f; l_run = 0.f;
                NS_DMA_KV(kcb, vcb, oc0, oc1, 0);
                if (ntl > 1) NS_DMA_KV(kcb + (size_t)64 * 256, vcb + (size_t)64 * 256, oc0, oc1, 1);
#pragma unroll 1
                for (int tl = 0; tl < ntl; ++tl) {
                    NS_WAIT_SYNC(tl + 1 < ntl, 4);
                    if (tl + 2 < ntl) NS_DMA_KV(kcb + (size_t)(tl + 2) * 64 * 256, vcb + (size_t)(tl + 2) * 64 * 256, oc0, oc1, (tl + 2) % 3);
                    ns_tile<0>(lds, NS_K + (tl % 3) * 16384, NS_V + (tl % 3) * 16384, 0u, false, Qf, kof0, vof0, tl + 2 >= ntl, -64, nlim - 64 * tl - 4 * hi, m_run, l_run, O, 0.f, improw, 0, r);
                }
                m_fin = m_run; inv_l = 1.0f / fmaxf(swap32_sum(l_run), 1e-30f);
                __syncthreads();
            }
            {
#pragma unroll
                for (int ct = 0; ct < 4; ++ct)
#pragma unroll
                    for (int i = 0; i < 16; ++i) O[ct][i] = 0.f;
                NS_DMA_KV(kcb, vcb, oc0, oc1, 0);
                if (ntl > 1) NS_DMA_KV(kcb + (size_t)64 * 256, vcb + (size_t)64 * 256, oc0, oc1, 1);
#pragma unroll 1
                for (int tl = 0; tl < ntl; ++tl) {
                    NS_WAIT_SYNC(tl + 1 < ntl, 4);
                    if (tl + 2 < ntl) NS_DMA_KV(kcb + (size_t)(tl + 2) * 64 * 256, vcb + (size_t)(tl + 2) * 64 * 256, oc0, oc1, (tl + 2) % 3);
                    m_run = m_fin;
                    ns_tile<1>(lds, NS_K + (tl % 3) * 16384, NS_V + (tl % 3) * 16384, 0u, false, Qf, kof0, vof0, tl + 2 >= ntl, -64, nlim - 64 * tl - 4 * hi, m_run, l_run, O, inv_l, improw, 16 * tl + hi, r);
                }
            }
            ns_emit_rows(lds, w, ntl % 3, (ntl + 1) % 3, ONSA + (size_t)(m0 + w * 8) * 1024 + g * 512, O, gate0, lane, false);
            }
#endif
            unsigned wv0 = 0u, wv1 = 0u, wv2 = 0u, wv3 = 0u;
            const int lane = lane_id_asm();
            LAS unsigned* qsel = (LAS unsigned*)(lds + NS_WM + 128) + w * 32;
            {
                unsigned kk[8][2], tau[8];
#pragma unroll
                for (int qq = 0; qq < 8; ++qq) { const int tqq = t0 + w * 8 + qq; const LAS float* ir = (const LAS float*)(lds + NS_IMP) + (w * 8 + qq) * NS_IMPROW; tau[qq] = 0u;
#pragma unroll
                    for (int hh = 0; hh < 2; ++hh) { const int j = lane + 64 * hh; float v = ir[j];
                        if (j == 0 || j == jt || j == jt - 1) v = 1e9f;
                        if (j * 64 > tqq) v = NEGF;
                        kk[qq][hh] = (f2key(v) & 0xFFFFFF80u) | (unsigned)(127 - j); } }
                int cacc[8];
#pragma unroll
                for (int qq = 0; qq < 8; ++qq) cacc[qq] = 128;
#pragma unroll 1
                for (int bit = 31; bit >= 0; --bit) {
                    bool alldone = true;
#pragma unroll
                    for (int qq = 0; qq < 8; ++qq) { const unsigned cand = tau[qq] | (1u << bit);
                        const int cnt = __popcll(__ballot(kk[qq][0] >= cand)) + __popcll(__ballot(kk[qq][1] >= cand)); if (cnt >= 16) { tau[qq] = cand; cacc[qq] = cnt; }
                        alldone = alldone && (cacc[qq] == 16); }
                    if (alldone) break;
                }
#pragma unroll
                for (int qq = 0; qq < 8; ++qq) {
                    const unsigned long long mlo = __ballot(kk[qq][0] >= tau[qq]), mhi = __ballot(kk[qq][1] >= tau[qq]);
                    const unsigned a0 = (unsigned)mlo, a1 = (unsigned)(mlo >> 32), a2 = (unsigned)mhi, a3 = (unsigned)(mhi >> 32);
                    if (lane == 0) { qsel[qq * 4 + 0] = a0; qsel[qq * 4 + 1] = a1; qsel[qq * 4 + 2] = a2; qsel[qq * 4 + 3] = a3; }
                    wv0 |= a0; wv1 |= a1; wv2 |= a2; wv3 |= a3;
                }
            }
            {
                const int nb = jt + 1;
                const unsigned f0 = nb >= 32 ? 0xFFFFFFFFu : ((1u << nb) - 1u), f1 = nb >= 64 ? 0xFFFFFFFFu : (nb > 32 ? ((1u << (nb - 32)) - 1u) : 0u);
                const unsigned f2 = nb >= 96 ? 0xFFFFFFFFu : (nb > 64 ? ((1u << (nb - 64)) - 1u) : 0u), f3 = nb >= 128 ? 0xFFFFFFFFu : (nb > 96 ? ((1u << (nb - 96)) - 1u) : 0u);
                wv0 &= f0; wv1 &= f1; wv2 &= f2; wv3 &= f3;
            }
            if (lane == 0) { LAS unsigned* wm = (LAS unsigned*)(lds + NS_WM) + w * 4; wm[0] = wv0; wm[1] = wv1; wm[2] = wv2; wm[3] = wv3; }
            __syncthreads();
            unsigned wg0 = 0u, wg1 = 0u, wg2 = 0u, wg3 = 0u;
#pragma unroll
            for (int ww = 0; ww < 8; ww += 4) {
                v4u wa = *(const LAS v4u*)(lds + NS_WM + ww * 16), wb = *(const LAS v4u*)(lds + NS_WM + ww * 16 + 16), wc = *(const LAS v4u*)(lds + NS_WM + ww * 16 + 32), wd = *(const LAS v4u*)(lds + NS_WM + ww * 16 + 48);
                asm volatile("" : "+v"(wa), "+v"(wb), "+v"(wc), "+v"(wd));
                wg0 |= (wa.x | wb.x) | (wc.x | wd.x); wg1 |= (wa.y | wb.y) | (wc.y | wd.y); wg2 |= (wa.z | wb.z) | (wc.z | wd.z); wg3 |= (wa.w | wb.w) | (wc.w | wd.w); }
            wg0 = __builtin_amdgcn_readfirstlane(wg0); wg1 = __builtin_amdgcn_readfirstlane(wg1); wg2 = __builtin_amdgcn_readfirstlane(wg2); wg3 = __builtin_amdgcn_readfirstlane(wg3);
#ifndef NS_SKIP_SLC
#ifndef NS_SLC_REPS
#define NS_SLC_REPS 1
#endif
            for (int rep_s = 0; rep_s < NS_SLC_REPS; ++rep_s) { NS_LANE_SETUP();
                m_run = 0.f; l_run = 0.f;
#pragma unroll
                for (int ct = 0; ct < 4; ++ct)
#pragma unroll
                    for (int i = 0; i < 16; ++i) O[ct][i] = 0.f;
                const bf16* ksb = KV + (size_t)(b * T) * KVW + 2 * 256 + g * 128; const bf16* vsb = ksb + 256;
                unsigned long long mlo = ((unsigned long long)wg1 << 32) | wg0, mhi = ((unsigned long long)wg3 << 32) | wg2;
                const unsigned long long wvlo = ((unsigned long long)wv1 << 32) | wv0, wvhi = ((unsigned long long)wv3 << 32) | wv2;
#define NS_POP(j_) do { if (mlo) { (j_) = __builtin_ctzll(mlo); mlo &= mlo - 1ull; } else if (mhi) { (j_) = 64 + __builtin_ctzll(mhi); mhi &= mhi - 1ull; } else (j_) = 128; } while (0)
                int j, jn; NS_POP(j); NS_POP(jn);
                NS_DMA_KV(ksb + (size_t)j * 64 * KVW, vsb + (size_t)j * 64 * KVW, okvA, okvB, 0); NS_DMA_T(j, 0);
                if (jn < 128) { NS_DMA_KV(ksb + (size_t)jn * 64 * KVW, vsb + (size_t)jn * 64 * KVW, okvA, okvB, 1); NS_DMA_T(jn, 1); }
                int b3 = 0;
#pragma unroll 1
                while (j < 128) {
                    NS_WAIT_SYNC(jn < 128, 5);
                    int jnn; NS_POP(jnn);
                    const int b3n = b3 == 0 ? 2 : b3 - 1;
                    if (jnn < 128) { NS_DMA_KV(ksb + (size_t)jnn * 64 * KVW, vsb + (size_t)jnn * 64 * KVW, okvA, okvB, b3n); NS_DMA_T(jnn, b3n); }
                    if (((j < 64 ? wvlo : wvhi) >> (j & 63)) & 1ull) {
                        const unsigned lselw = qsel[qi * 4 + (j >> 5)];
                        const bool lsel = (lselw >> (j & 31)) & 1u;
                        const int dd = jt - j; const bool constb = dd >= 64 ? true : (bool)((0xffff9ffeff3ee680ull >> dd) & 1ull);
                        const unsigned trow = (unsigned)(NS_T + b3 * NS_TBUF + r * NS_TROW);
                        const float cbv = constb ? *(const LAS float*)(lds + trow + 63 * 4) : 0.f;
                        ns_tile<2>(lds, NS_K + b3 * 16384, NS_V + b3 * 16384, trow + (unsigned)((63 - qoff + 4 * hi) * 4), constb, Qf, kof0, vof0, j == jt, -64, qoff - 4 * hi, m_run, l_run, O, 0.f, improw, 0, r, cbv, !lsel);
                    }
                    j = jn; jn = jnn; b3 = b3 == 2 ? 0 : b3 + 1;
                }
#undef NS_POP
                __syncthreads();
                if (rep_s == NS_SLC_REPS - 1) ns_emit_rows(lds, w, 0, 1, ONSA + (size_t)(m0 + w * 8) * 1024 + g * 512, O, gate1 / fmaxf(swap32_sum(l_run), 1e-30f), lane, true);
            }
#endif
#ifndef NS_SKIP_WIN
            { NS_LANE_SETUP();
                m_run = 0.f; l_run = 0.f;
#pragma unroll
                for (int ct = 0; ct < 4; ++ct)
#pragma unroll
                    for (int i = 0; i < 16; ++i) O[ct][i] = 0.f;
                const bf16* kwb = KV + (size_t)(b * T) * KVW + 4 * 256 + g * 128; const bf16* vwb = kwb + 256;
                const int j0 = jt >= 8 ? jt - 8 : 0;
                NS_DMA_KV(kwb + (size_t)j0 * 64 * KVW, vwb + (size_t)j0 * 64 * KVW, okvA, okvB, 0); NS_DMA_T(j0, 0);
                if (j0 < jt) { NS_DMA_KV(kwb + (size_t)(j0 + 1) * 64 * KVW, vwb + (size_t)(j0 + 1) * 64 * KVW, okvA, okvB, 1); NS_DMA_T(j0 + 1, 1); }
                int b3 = 0;
#pragma unroll 1
                for (int j = j0; j <= jt; ++j, b3 = b3 == 2 ? 0 : b3 + 1) {
                    const int b3n = b3 == 0 ? 2 : b3 - 1;
                    NS_WAIT_SYNC(j < jt, 5);
                    if (j + 2 <= jt) { NS_DMA_KV(kwb + (size_t)(j + 2) * 64 * KVW, vwb + (size_t)(j + 2) * 64 * KVW, okvA, okvB, b3n); NS_DMA_T(j + 2, b3n); }
                    const unsigned tbase = (unsigned)(NS_T + b3 * NS_TBUF + r * NS_TROW + (63 - qoff + 4 * hi) * 4);
                    const bool first = (j == jt - 8), diag = (j == jt);
                    ns_tile<2>(lds, NS_K + b3 * 16384, NS_V + b3 * 16384, tbase, false, Qf, kof0, vof0, first || diag, first ? qoff + 1 - 4 * hi : -64, diag ? qoff - 4 * hi : 1000, m_run, l_run, O, 0.f, improw, 0, r);
                }
                __syncthreads();
                ns_emit_rows(lds, w, 0, 1, ONSA + (size_t)(m0 + w * 8) * 1024 + g * 512, O, gate2 / fmaxf(swap32_sum(l_run), 1e-30f), lane, true);
            }
#endif
        }
    }
#undef NS_DMA_KV
#undef NS_DMA_T
#undef NS_WAIT_SYNC
#undef NS_OFF
#undef NS_LANE_SETUP
#undef gate0
#undef gate1
#undef gate2
#undef okv0
#undef okv1
#undef oc0
#undef oc1
}


constexpr int DA_WSTRIDE = 17664, DA_SEL = 16384, DA_BK = 17408, DA_RB = 8 * DA_WSTRIDE;
__device__ __forceinline__ void ph_dsa_attn_mfma(const Frame& F, const Params& P) {
    unsigned char* ws = P.ws;
    const bf16* QABS = (const bf16*)(ws + WS_QABS); const bf16* CKV = (const bf16*)(ws + WS_CKV); const unsigned short* SEL = (const unsigned short*)(ws + WS_SEL);
    bf16* OLAT = (bf16*)(ws + WS_XN);
    LAS unsigned char* lds = F.lds;
    const int lane = F.lane, w = F.wave, h16 = lane & 15, g4 = lane >> 4;
    LAS unsigned char* wl = lds + w * DA_WSTRIDE;
    for (int i = F.tid; i < 264; i += NTHR) ((LAS float*)(lds + DA_RB))[i] = i < 256 ? P.in[5][i] * 1.4426950408889634f : NEGF;
    __syncthreads();
    const LAS float* rb2 = (const LAS float*)(lds + DA_RB) + (h16 & 7);
    const unsigned kr0 = 256u * h16 + 16u * (((unsigned)g4) ^ ((((unsigned)h16 & 3) << 2) | (((unsigned)h16 >> 2) & 3)));
    const unsigned q_ = ((unsigned)h16) >> 2, p_ = (unsigned)h16 & 3;
    const unsigned vt0 = 256u * (4 * g4 + q_) + 8u * (p_ & 1) + 16u * (((p_ >> 1)) ^ ((q_ << 2) | (unsigned)g4));
    const unsigned dpos = (unsigned)h16, drl = (unsigned)g4;
    const int nq = 16;
    for (int p = blockIdx.x; p < 256; p += F.G) {
    const int ix_ = (p >> 3) * 2 + (p & 1), bq_ = (p & 7) >> 1;
#define DA_Q(qn_) (bq_ * T + (((qn_) & 8) ? 127 - ix_ : ix_) * 64 + w * 8 + ((qn_) & 7))
#define DA_DMA(bq, sb, ch, kb) do { \
        unsigned sv8_[8];         \
        _Pragma("unroll") for (int ii = 0; ii < 8; ++ii) sv8_[ii] = *(const LAS unsigned short*)(wl + DA_SEL + (sb) * 512 + (32 * (ch) + 4 * ii + (int)drl) * 2); \
        _Pragma("unroll") for (int ii = 0; ii < 8; ++ii) { \
            const unsigned sv_ = sv8_[ii]; \
            const unsigned row_ = sv_ < 8191u ? sv_ : 8191u;        \
            const bf16* src_ = CKV + ((size_t)(bq) * T + row_) * 128 + ((dpos ^ ((drl << 2) | (unsigned)(ii & 3))) * 8); \
            __builtin_amdgcn_global_load_lds((const unsigned*)src_, (LAS unsigned*)(wl + (kb) * 8192 + ii * 1024), 16, 0, 0); } } while (0)
    {
        const int m = DA_Q(0);
        const v2u sv = *((const v2u*)(SEL + (size_t)m * 256) + lane);
        *((LAS v2u*)(wl + DA_SEL) + lane) = sv;
        LDS_WAIT(); asm volatile("" ::: "memory");
        DA_DMA(m >> 13, 0, 0, 0);
    }
#pragma unroll 1
    for (int qn = 0; qn < nq; ++qn) {
        const int m = DA_Q(qn), mnext = DA_Q(qn + 1), b = m >> 13, t = m & 8191, sb = qn & 1;
        v2u svn; svn.x = 0u; svn.y = 0u;
        if (qn + 1 < nq) svn = *((const v2u*)(SEL + (size_t)mnext * 256) + lane);
        bf16x8v Qf[4];
#pragma unroll
        for (int ks = 0; ks < 4; ++ks) { v4u z; z.x = 0u; z.y = 0u; z.z = 0u; z.w = 0u;
            if (h16 < 8) z = *(const v4u*)(QABS + (size_t)m * 1024 + h16 * 128 + 32 * ks + 8 * g4);
            Qf[ks] = __builtin_bit_cast(bf16x8v, z); }
        f32x4 O[8]; float m_run = 0.f, l_run = 0.f;
#pragma unroll
        for (int ct = 0; ct < 8; ++ct) O[ct] = (f32x4){0.f, 0.f, 0.f, 0.f};
        {
            const v2u s4 = *((const LAS v2u*)(wl + DA_SEL + sb * 512) + lane);
            const unsigned sv4[4] = {s4.x & 0xffffu, s4.x >> 16, s4.y & 0xffffu, s4.y >> 16};
            unsigned pk = 0u;
#pragma unroll
            for (int i = 0; i < 4; ++i) { const unsigned bk_ = sv4[i] == 0xFFFFu ? 32u : (unsigned)rel_bucket(t - (int)sv4[i]); pk |= bk_ << (8 * i); }
            *((LAS unsigned*)(wl + DA_BK) + lane) = pk;
            LDS_WAIT(); asm volatile("" ::: "memory");
        }
        unsigned nb0 = *((const LAS unsigned*)(wl + DA_BK) + g4), nb1 = *((const LAS unsigned*)(wl + DA_BK) + 4 + g4);
#pragma unroll 1
        for (int ch = 0; ch < 8; ++ch) {
            const int it = qn * 8 + ch, kb = it & 1;
            if (ch < 7) { DA_DMA(b, sb, ch + 1, kb ^ 1); asm volatile("s_waitcnt vmcnt(8)" ::: "memory"); }
            else if (qn + 1 < nq) { *((LAS v2u*)(wl + DA_SEL + (sb ^ 1) * 512) + lane) = svn; LDS_WAIT(); asm volatile("" ::: "memory");
                                    DA_DMA(mnext >> 13, sb ^ 1, 0, kb ^ 1); asm volatile("s_waitcnt vmcnt(8)" ::: "memory"); }
            else asm volatile("s_waitcnt vmcnt(0)" ::: "memory");
            const LAS unsigned char* kbuf = wl + kb * 8192;
            f32x4 D0, D1;
            { const unsigned b0 = nb0, b1 = nb1;
              if (ch < 7) { nb0 = *((const LAS unsigned*)(wl + DA_BK) + 8 * (ch + 1) + g4); nb1 = *((const LAS unsigned*)(wl + DA_BK) + 8 * (ch + 1) + 4 + g4); }
#pragma unroll
              for (int i = 0; i < 4; ++i) { D0[i] = rb2[((b0 >> (8 * i)) & 0xffu) * 8]; D1[i] = rb2[((b1 >> (8 * i)) & 0xffu) * 8]; } }
            {
                const unsigned kb_ = (unsigned)(uintptr_t)kbuf; const unsigned a0_ = kb_ + kr0, a1_ = kb_ + (kr0 ^ 64u), a2_ = kb_ + (kr0 ^ 128u), a3_ = kb_ + (kr0 ^ 192u);
                bf16x8v f0, f1, f2, f3, f4, f5, f6, f7;
                asm volatile("ds_read_b128 %0, %8\n\tds_read_b128 %1, %8 offset:4096\n\tds_read_b128 %2, %9\n\tds_read_b128 %3, %9 offset:4096\n\t"
                             "ds_read_b128 %4, %10\n\tds_read_b128 %5, %10 offset:4096\n\tds_read_b128 %6, %11\n\tds_read_b128 %7, %11 offset:4096\n\ts_waitcnt lgkmcnt(0)"
                             : "=&v"(f0), "=&v"(f1), "=&v"(f2), "=&v"(f3), "=&v"(f4), "=&v"(f5), "=&v"(f6), "=&v"(f7) : "v"(a0_), "v"(a1_), "v"(a2_), "v"(a3_) : "memory");
                D0 = __builtin_amdgcn_mfma_f32_16x16x32_bf16(f0, Qf[0], D0, 0, 0, 0); D1 = __builtin_amdgcn_mfma_f32_16x16x32_bf16(f1, Qf[0], D1, 0, 0, 0);
                D0 = __builtin_amdgcn_mfma_f32_16x16x32_bf16(f2, Qf[1], D0, 0, 0, 0); D1 = __builtin_amdgcn_mfma_f32_16x16x32_bf16(f3, Qf[1], D1, 0, 0, 0);
                D0 = __builtin_amdgcn_mfma_f32_16x16x32_bf16(f4, Qf[2], D0, 0, 0, 0); D1 = __builtin_amdgcn_mfma_f32_16x16x32_bf16(f5, Qf[2], D1, 0, 0, 0);
                D0 = __builtin_amdgcn_mfma_f32_16x16x32_bf16(f6, Qf[3], D0, 0, 0, 0); D1 = __builtin_amdgcn_mfma_f32_16x16x32_bf16(f7, Qf[3], D1, 0, 0, 0);
            }
            { const float mx = fmaxf(fmaxf(fmaxf(D0[0], D0[1]), fmaxf(D0[2], D0[3])), fmaxf(fmaxf(D1[0], D1[1]), fmaxf(D1[2], D1[3])));
              if (__ballot(mx > m_run + 60.f) != 0ull) {
                float mxx = fmaxf(mx, __shfl_xor(mx, 16)); mxx = fmaxf(mxx, __shfl_xor(mxx, 32));
                const float m_new = fmaxf(m_run, mxx);
                const float sc = __builtin_amdgcn_exp2f(m_run - m_new); l_run *= sc;
#pragma unroll
                for (int ct = 0; ct < 8; ++ct) O[ct] *= sc;
                m_run = m_new;
              } }
            const unsigned vb_ = (unsigned)(uintptr_t)kbuf;
            v2u lo[8], hi_[8];
#define DA_TR4(c0) asm volatile("ds_read_b64_tr_b16 %0, %8\n\tds_read_b64_tr_b16 %1, %8 offset:4096\n\tds_read_b64_tr_b16 %2, %9\n\tds_read_b64_tr_b16 %3, %9 offset:4096\n\t" \
                             "ds_read_b64_tr_b16 %4, %10\n\tds_read_b64_tr_b16 %5, %10 offset:4096\n\tds_read_b64_tr_b16 %6, %11\n\tds_read_b64_tr_b16 %7, %11 offset:4096" \
                             : "=&v"(lo[c0]), "=&v"(hi_[c0]), "=&v"(lo[c0 + 1]), "=&v"(hi_[c0 + 1]), "=&v"(lo[c0 + 2]), "=&v"(hi_[c0 + 2]), "=&v"(lo[c0 + 3]), "=&v"(hi_[c0 + 3]) \
                             : "v"(vb_ + (vt0 ^ (32u * (c0)))), "v"(vb_ + (vt0 ^ (32u * (c0 + 1)))), "v"(vb_ + (vt0 ^ (32u * (c0 + 2)))), "v"(vb_ + (vt0 ^ (32u * (c0 + 3)))) : "memory")
            DA_TR4(0); DA_TR4(4);
#undef DA_TR4
            float pv[8];
#pragma unroll
            for (int i = 0; i < 4; ++i) { pv[i] = __builtin_amdgcn_exp2f(D0[i] - m_run); pv[4 + i] = __builtin_amdgcn_exp2f(D1[i] - m_run); }
            l_run += ((pv[0] + pv[1]) + (pv[2] + pv[3])) + ((pv[4] + pv[5]) + (pv[6] + pv[7]));
            v4u pw; pw.x = cvtpk(pv[0], pv[1]); pw.y = cvtpk(pv[2], pv[3]); pw.z = cvtpk(pv[4], pv[5]); pw.w = cvtpk(pv[6], pv[7]);
            const bf16x8v pf = __builtin_bit_cast(bf16x8v, pw);
            {
                asm volatile("s_waitcnt lgkmcnt(8)" : "+v"(lo[0]), "+v"(hi_[0]), "+v"(lo[1]), "+v"(hi_[1]), "+v"(lo[2]), "+v"(hi_[2]), "+v"(lo[3]), "+v"(hi_[3]) :: "memory");
#pragma unroll
                for (int ct = 0; ct < 4; ++ct) O[ct] = __builtin_amdgcn_mfma_f32_16x16x32_bf16(vcat(lo[ct], hi_[ct]), pf, O[ct], 0, 0, 0);
                asm volatile("s_waitcnt lgkmcnt(0)" : "+v"(lo[4]), "+v"(hi_[4]), "+v"(lo[5]), "+v"(hi_[5]), "+v"(lo[6]), "+v"(hi_[6]), "+v"(lo[7]), "+v"(hi_[7]) :: "memory");
#pragma unroll
                for (int ct = 4; ct < 8; ++ct) O[ct] = __builtin_amdgcn_mfma_f32_16x16x32_bf16(vcat(lo[ct], hi_[ct]), pf, O[ct], 0, 0, 0);
            }
        }
        float lt = l_run; lt += __shfl_xor(lt, 16); lt += __shfl_xor(lt, 32);
        const float inv = 1.0f / fmaxf(lt, 1e-30f);
        if (h16 < 8) { bf16* orow = OLAT + (size_t)m * 1024 + h16 * 128 + 4 * g4;
#pragma unroll
            for (int ct = 0; ct < 8; ++ct) { v2u o; o.x = cvtpk(O[ct][0] * inv, O[ct][1] * inv); o.y = cvtpk(O[ct][2] * inv, O[ct][3] * inv); *(v2u*)(orow + 16 * ct) = o; } }
    }
    }
#undef DA_DMA
#undef DA_Q
}

typedef GAS unsigned gu32;
#define RLX_AGENT __ATOMIC_RELAXED, __HIP_MEMORY_SCOPE_AGENT
#define XB_TMO      128
#define XB_XCNT(j)  (256  + 64 * (j))
#define XB_XSUB(j)  (1280 + 64 * (j))
#define XB_XGEN(j)  (2304 + 64 * (j))
#define XB_TOP      3328
#define XB_TOPGEN   3392
#define XCD_BAR_WORDS 3456
#define XB_SPIN_CAP (1u << 18)

__device__ __forceinline__ unsigned xb_ld(unsigned* p)              { return __hip_atomic_load(p, __ATOMIC_RELAXED, __HIP_MEMORY_SCOPE_AGENT); }
__device__ __forceinline__ unsigned xb_add(unsigned* p, unsigned v) { return __hip_atomic_fetch_add(p, v, __ATOMIC_RELAXED, __HIP_MEMORY_SCOPE_AGENT); }
__device__ __forceinline__ unsigned xb_xcc_id() { return (unsigned)__builtin_amdgcn_s_getreg((3 << 11) | 20) & 0xFu; }
#define XB_SPIN(cond, bar) do { unsigned _sp = 0; while (cond) { __builtin_amdgcn_s_sleep(1); \
    if ((++_sp & 255u) == 0u) { if (xb_ld(&(bar)[XB_TMO])) break; if (_sp > XB_SPIN_CAP) { atomicAdd(&(bar)[XB_TMO], 1u); break; } } } } while (0)

struct XcdBarrier {
    unsigned* bar; unsigned x;
    volatile LAS unsigned* st;
};

__device__ __forceinline__ XcdBarrier xcd_barrier_post(unsigned* bar, volatile LAS unsigned* st) {
    XcdBarrier b; b.bar = bar; b.x = xb_xcc_id(); b.st = st;
    if (threadIdx.x == 0) (void)xb_add(&bar[XB_XCNT(b.x)], 1u);
    return b;
}
__device__ __forceinline__ void xcd_barrier_complete(unsigned* bar, unsigned x, unsigned& nloc, unsigned& nx) {
    const unsigned G = gridDim.x * gridDim.y * gridDim.z;
    unsigned sum, cnt, mine, sp = 0u;
    for (;;) {
        sum = 0u; cnt = 0u; mine = 0u;
#pragma unroll
        for (unsigned j = 0; j < 16; ++j) { const unsigned c = xb_ld(&bar[XB_XCNT(j)]); sum += c; cnt += (c > 0u) ? 1u : 0u; mine = (j == x) ? c : mine; }
        if (sum == G) break;
        __builtin_amdgcn_s_sleep(1);
        if ((++sp & 255u) == 0u) { if (xb_ld(&bar[XB_TMO])) break; if (sp > XB_SPIN_CAP) { atomicAdd(&bar[XB_TMO], 1u); break; } }
    }
    nloc = mine > 0u ? mine : 1u; nx = cnt > 0u ? cnt : 1u;
}

__device__ __forceinline__ void xcd_barrier(const XcdBarrier& b, const int wave_sgpr) {
    asm volatile("s_waitcnt vmcnt(0)" ::: "memory");
    __syncthreads();
    if (wave_sgpr == 0 && lane_id_asm() == 0) {
        unsigned* bar = b.bar;
        __builtin_amdgcn_s_waitcnt(0);
        unsigned nloc = b.st[0], nx = b.st[1];
        if (nloc == 0u) { xcd_barrier_complete(bar, b.x, nloc, nx); b.st[0] = nloc; b.st[1] = nx; }
        const unsigned old = xb_add(&bar[XB_XSUB(b.x)], 1u);
        const unsigned gen = old / nloc;
        if (old + 1u == (gen + 1u) * nloc) {
            __builtin_amdgcn_fence(__ATOMIC_RELEASE, "agent");
            asm volatile("s_waitcnt vmcnt(0)" ::: "memory");
            const unsigned og = xb_add(&bar[XB_TOP], 1u);
            const unsigned tg = og / nx;
            if (og + 1u == (tg + 1u) * nx) xb_add(&bar[XB_TOPGEN], 1u);
            else XB_SPIN(xb_ld(&bar[XB_TOPGEN]) == tg, bar);
            __builtin_amdgcn_fence(__ATOMIC_ACQUIRE, "agent");
            xb_add(&bar[XB_XGEN(b.x)], 1u);
            asm volatile("s_waitcnt vmcnt(0)" ::: "memory");
        } else {
            XB_SPIN(xb_ld(&bar[XB_XGEN(b.x)]) == gen, bar);
            __builtin_amdgcn_fence(__ATOMIC_ACQUIRE, "agent");
            asm volatile("s_waitcnt vmcnt(0)" ::: "memory");
        }
    }
    __syncthreads();
}

enum Phase { PH_PROLOGUE = 0, PH_G1, PH_PREP, PH_G2, PH_INDEX, PH_DSA_ATTN, PH_G3, PH_NORM1, PH_UP0, PH_DN0, PH_NORM2, PH_G6, PH_CMP_GATHER, PH_CMP_GEMM, PH_CMP_REDUCE,
             PH_NSA_ATTN, PH_G7, PH_NORM3, PH_UP1, PH_DN1, PH_FINAL, PH_COUNT };

__global__ void __launch_bounds__(NTHR, 2) mk_fwd(Params P) {
    extern __shared__ __attribute__((aligned(16))) unsigned char lds[];
    Frame F;
    F.lds = (LAS unsigned char*)lds;
    F.tid = threadIdx.x; F.lane = F.tid & 63; F.wave = __builtin_amdgcn_readfirstlane(F.tid >> 6);
    F.G = gridDim.x; F.gw = blockIdx.x * NWAVES + F.wave; F.NGW = F.G * NWAVES;
    unsigned char* ws = P.ws;
    const int lo = P.ph_lo, hi = P.ph_hi; (void)lo; (void)hi;
    volatile LAS unsigned* MISC = (volatile LAS unsigned*)(F.lds + LDS_BYTES - 64);
    if (F.tid < 16) MISC[F.tid] = 0u;
    __syncthreads();
    XcdBarrier bar = xcd_barrier_post((unsigned*)ws, MISC + 8);
    pg8::bf16_t* XN = (pg8::bf16_t*)(ws + WS_XN);
#ifndef MK_PH_MASK
#define MK_PH_MASK 0xFFFFFFFFu
#endif
#ifdef MK_CUTS
#define IN(k) (((MK_PH_MASK >> (k)) & 1u) && lo <= (k) && (k) < hi)
#else
#define IN(k) ((MK_PH_MASK >> (k)) & 1u)
#endif
#ifndef MK_REPEAT
#define MK_REPEAT -1
#endif
#define RP(k) for (int rep_ = 0; rep_ < ((MK_REPEAT == (k)) ? 2 : 1); ++rep_)
#define REFRAME() do { F.lane = lane_id_asm(); F.tid = F.wave * 64 + F.lane; } while (0)
#define SEAM(k) do { if (IN(k) && IN((k) + 1)) xcd_barrier(bar, F.wave); } while (0)
#define GEMM_PHASE_RC(EpiT, gemm, epi) do { typedef pg8::ChunkOrder<M / 256, FF / 1024> CO_; CO_ S_{F.G, (int)blockIdx.x}; \
        pg8::gemm_phase<EpiT, CO_, true, true, false>((PG8_LAS unsigned char*)F.lds, (gemm), S_, (epi), F.wave, (const float*)(ws + WS_SSQ)); } while (0)
#define GEMM_PHASE_R(EpiT, gemm, epi) do { pg8::StaticOrder S_; S_.init((gemm).M, (gemm).N, F.G, (int)blockIdx.x); \
        pg8::gemm_phase<EpiT, pg8::StaticOrder, true, true, false>((PG8_LAS unsigned char*)F.lds, (gemm), S_, (epi), F.wave, (const float*)(ws + WS_SSQ)); } while (0)
#define GEMM_PHASE(EpiT, gemm, epi, F16_) do { pg8::StaticOrder S_; S_.init((gemm).M, (gemm).N, F.G, (int)blockIdx.x); \
        pg8::gemm_phase<EpiT, pg8::StaticOrder, true, true, F16_>((PG8_LAS unsigned char*)F.lds, (gemm), S_, (epi), F.wave); } while (0)

    if (IN(PH_PROLOGUE)) RP(PH_PROLOGUE) { REFRAME(); ph_prologue(F, P); }
    SEAM(PH_PROLOGUE);
    if (IN(PH_G1)) RP(PH_G1) {
        pg8::Gemm g{XN, (const pg8::bf16_t*)(ws + WS_W_IN0), M, 512, D};
        pg8::EpiPrep E{(pg8::bf16_t*)(ws + WS_CQ), (pg8::bf16_t*)(ws + WS_CKV), (pg8::bf16_t*)(ws + WS_KIDX), (float*)(ws + WS_WIDX), P.in[8], P.in[9], WIDX_SCALE};
        GEMM_PHASE(pg8::EpiPrep, g, E, true);
    }
    SEAM(PH_G1);
    if (IN(PH_G2)) RP(PH_G2) {
        { pg8::Gemm g{(const pg8::bf16_t*)(ws + WS_CQ), (const pg8::bf16_t*)(ws + WS_W_Q2), M, 1024, 256}; pg8::EpiPk<false> E{(pg8::bf16_t*)(ws + WS_QABS), 1024};
          GEMM_PHASE(pg8::EpiPk<false>, g, E, true); }
        { pg8::Gemm g{(const pg8::bf16_t*)(ws + WS_CQ), (const pg8::bf16_t*)(ws + WS_W_Q2) + (size_t)1024 * 256, M, 512, 256}; pg8::EpiPk<true> E{(pg8::bf16_t*)(ws + WS_QIDX), 512};
          GEMM_PHASE(pg8::EpiPk<true>, g, E, true); }
    }
    SEAM(PH_G2);
    if (IN(PH_INDEX)) RP(PH_INDEX) { REFRAME(); ph_index_mfma(F, P); }
    if (IN(PH_INDEX) && IN(PH_DSA_ATTN)) { asm volatile("s_waitcnt vmcnt(0)" ::: "memory"); __syncthreads(); }
    if (IN(PH_DSA_ATTN)) RP(PH_DSA_ATTN) { REFRAME(); ph_dsa_attn_mfma(F, P); }
    SEAM(PH_DSA_ATTN);
    if (IN(PH_G3)) {
        pg8::Gemm g{XN, (const pg8::bf16_t*)(ws + WS_W_UVO), M, D, D}; pg8::EpiResB<true> E{P.in[0], (pg8::bf16_t*)(ws + WS_RB), (float*)(ws + WS_SSQ), D};
        GEMM_PHASE(pg8::EpiResB<true>, g, E, false);
    }
    SEAM(PH_G3);
#define MLP_PHASES(l, base) \
    if (IN((base) + 1)) RP(PH_UP0) {     \
        pg8::Gemm g{(const pg8::bf16_t*)(ws + WS_RB), (const pg8::bf16_t*)(ws + WS_W_UP) + (size_t)(l) * FF * D, M, FF, D}; pg8::EpiRelu2 E{(pg8::bf16_t*)(ws + WS_U), FF, (PG8_LAS unsigned char*)F.lds}; \
        GEMM_PHASE_RC(pg8::EpiRelu2, g, E); \
    } \
    SEAM((base) + 1); \
    if (IN((base) + 2)) {     \
        pg8::Gemm g{(const pg8::bf16_t*)(ws + WS_U), (const pg8::bf16_t*)(ws + WS_W_DN) + (size_t)(l) * D * FF, M, D, FF}; pg8::EpiResB<false> E{nullptr, (pg8::bf16_t*)(ws + WS_RB), (float*)(ws + WS_SSQ), D}; \
        GEMM_PHASE(pg8::EpiResB<false>, g, E, false); \
    } \
    SEAM((base) + 2);
    MLP_PHASES(0, PH_NORM1)
    if (IN(PH_G6)) RP(PH_G6) {
        pg8::Gemm g{(const pg8::bf16_t*)(ws + WS_RB), (const pg8::bf16_t*)(ws + WS_W_KVQ), M, 2560, D}; pg8::EpiKVQ E{(pg8::bf16_t*)(ws + WS_KV), (pg8::bf16_t*)(ws + WS_QN), (PG8_LAS unsigned char*)F.lds, (pg8::bf16_t*)(ws + WS_FLAT), P.in[17], P.in[18]};
        GEMM_PHASE_R(pg8::EpiKVQ, g, E);
    }
    SEAM(PH_G6);
    if (IN(PH_CMP_GEMM)) RP(PH_CMP_GEMM) {
        pg8::Gemm g{(const pg8::bf16_t*)(ws + WS_FLAT), (const pg8::bf16_t*)(ws + WS_W_C1), 32768, 2048, 1024}; pg8::EpiPart E{(float*)(ws + WS_PART)};
        CmpOrder S_{F.G, (int)blockIdx.x};
        pg8::gemm_phase<pg8::EpiPart, CmpOrder, true, true>((PG8_LAS unsigned char*)F.lds, g, S_, E, F.wave);
        pg8::Gemm gg{(const pg8::bf16_t*)(ws + WS_RB), (const pg8::bf16_t*)(ws + WS_W_KVQ) + (size_t)2560 * D, M, 256, D}; pg8::EpiGate EG{(float*)(ws + WS_GATES), (PG8_LAS unsigned char*)F.lds};
        GateOrder SG_{F.G, (int)blockIdx.x};
        pg8::gemm_phase<pg8::EpiGate, GateOrder, true, true>((PG8_LAS unsigned char*)F.lds, gg, SG_, EG, F.wave, (const float*)(ws + WS_SSQ));
    }
    SEAM(PH_CMP_GEMM);
    if (IN(PH_CMP_REDUCE)) RP(PH_CMP_REDUCE) { REFRAME(); ph_cmp_reduce(F, P); }
    SEAM(PH_CMP_REDUCE);
    if (IN(PH_NSA_ATTN)) RP(PH_NSA_ATTN) { REFRAME(); ph_nsa_attn_flash(F, P); }
    SEAM(PH_NSA_ATTN);
    if (IN(PH_G7)) {
        pg8::Gemm g{XN, (const pg8::bf16_t*)(ws + WS_W_O1), M, D, D}; pg8::EpiResB<false> E{nullptr, (pg8::bf16_t*)(ws + WS_RB), (float*)(ws + WS_SSQ), D};
        GEMM_PHASE(pg8::EpiResB<false>, g, E, false);
    }
    SEAM(PH_G7);
    MLP_PHASES(1, PH_NORM3)
#undef MLP_PHASES
    if (IN(PH_FINAL)) { REFRAME(); ph_final_norm(F, (const bf16*)(ws + WS_RB), (const float*)(ws + WS_SSQ), P.out, P.in[25]); }
#undef IN
#undef SEAM
#undef GEMM_PHASE
}

extern "C" void kernel_launch(void* const* d_in, const int* in_sizes, int n_in, void* d_out, int out_size, void* d_ws, size_t ws_size, hipStream_t stream) {
    static int grid = 0;
    if (grid == 0) {
        if (n_in != 26 || out_size != M * D || ws_size < WS_END) { fprintf(stderr, "kernel_launch: unexpected problem (n_in %d, out %d, ws %zu); nothing launched\n", n_in, out_size, ws_size); grid = -1; return; }
        int dev = 0, cus = 0, per_cu = 0;
        if (hipGetDevice(&dev) != hipSuccess || hipDeviceGetAttribute(&cus, hipDeviceAttributeMultiprocessorCount, dev) != hipSuccess) { grid = -1; return; }
        if (hipFuncSetAttribute((const void*)mk_fwd, hipFuncAttributeMaxDynamicSharedMemorySize, LDS_BYTES) != hipSuccess) { fprintf(stderr, "kernel_launch: hipFuncSetAttribute failed\n"); grid = -1; return; }
        if (hipOccupancyMaxActiveBlocksPerMultiprocessor(&per_cu, (const void*)mk_fwd, NTHR, LDS_BYTES) != hipSuccess || per_cu < 1) { fprintf(stderr, "kernel_launch: occupancy query says %d\n", per_cu); per_cu = 1; }
        (void)hipGetLastError();
        grid = cus * (per_cu > 1 ? 1 : per_cu);
        if (grid != 256) fprintf(stderr, "kernel_launch: note: %d workgroups\n", grid);
    }
    if (grid < 0) return;
    if (hipMemsetAsync(d_ws, 0, 16384, stream) != hipSuccess) { fprintf(stderr, "kernel_launch: memset failed\n"); return; }
    Params p{};
    for (int i = 0; i < 26; ++i) p.in[i] = (const float*)d_in[i];
    p.out = (float*)d_out; p.ws = (unsigned char*)d_ws;
#ifndef MK_CUTS
    p.ph_lo = 0; p.ph_hi = PH_COUNT;
    void* args[] = {&p};
    hipError_t e = hipLaunchCooperativeKernel((const void*)mk_fwd, dim3(grid), dim3(NTHR), args, LDS_BYTES, stream);
    if (e != hipSuccess) fprintf(stderr, "cooperative launch failed: %s (grid %d)\n", hipGetErrorString(e), grid);
#else
    for (int k = 0; k < PH_COUNT; ++k) {
        p.ph_lo = k; p.ph_hi = k + 1;
        void* args[] = {&p};
        hipError_t e = hipLaunchCooperativeKernel((const void*)mk_fwd, dim3(grid), dim3(NTHR), args, LDS_BYTES, stream);
        if (e != hipSuccess) { fprintf(stderr, "launch %d failed: %s\n", k, hipGetErrorString(e)); break; }
    }
#endif
}
```
